# Optimizing an MI355X kernel written in HIP

```python
import jax, jax.numpy as jnp
from jax import lax
import numpy as np

D_MODEL = 1024
BATCH = 4
SEQ = 4096
DEPTH = 1

CHUNK = 64
EPS = 1e-6
D_MIX = D_MODEL
MLSTM_HEADS = 4
MLSTM_HEAD_DIM = (D_MIX // 2) // MLSTM_HEADS
MLSTM_WIDTH = MLSTM_HEADS * MLSTM_HEAD_DIM
CONV_WIDTH = 4
GMLP_GROUPS = 4
GMLP_WIDTH = D_MIX - MLSTM_WIDTH
GMLP_GROUP_DIM = GMLP_WIDTH // GMLP_GROUPS
GMLP_CHUNK = 128
D_IN_PROJ = 4 * MLSTM_WIDTH + 2 * MLSTM_HEADS + 2 * GMLP_WIDTH
PEER_HEADS = 8
PEER_KEYS = 128
PEER_EXPERTS = PEER_KEYS * PEER_KEYS
PEER_QUERY_DIM = 256
PEER_HALF = PEER_QUERY_DIM // 2
PEER_TOPK = 16
PEER_BLOCK = 128

kernel_name = "hymba_mlstm_gmlp_peer_block"


def rmsnorm(x, g):
    xf = x.astype(jnp.float32)
    y = xf * lax.rsqrt(jnp.mean(xf * xf, axis=-1, keepdims=True) + EPS)
    return (y * g.astype(jnp.float32)).astype(x.dtype)


def causal_conv(x, w, b):
    S = x.shape[1]
    xp = jnp.pad(x, ((0, 0), (CONV_WIDTH - 1, 0), (0, 0)))
    out = b
    for j in range(CONV_WIDTH):
        out = out + xp[:, j:j + S] * w[j]
    return out


def mlstm_chunkwise(q, k, v, ig, lf):
    B, H, S, Dh = q.shape
    nc = S // CHUNK

    def to_chunks(a):
        a = a.reshape(B, H, nc, CHUNK, *a.shape[3:])
        return jnp.moveaxis(a, 2, 0)

    causal = jnp.tril(jnp.ones((CHUNK, CHUNK), dtype=bool))

    def step(carry, xs):
        C, n, m = carry
        qc, kc, vc, igc, lfc = xs
        b = jnp.cumsum(lfc, axis=-1)
        D = b[..., :, None] - b[..., None, :] + igc[..., None, :]
        D = jnp.where(causal, D, -jnp.inf)
        inter = b + m[..., None]
        m_t = jnp.maximum(inter, jnp.max(D, axis=-1))
        w = jnp.exp(D - m_t[..., None])
        s = jnp.einsum('bhtd,bhsd->bhts', qc, kc) * w
        sc = jnp.exp(inter - m_t)
        num = jnp.einsum('bhts,bhsd->bhtd', s, vc) + sc[..., None] * jnp.einsum('bhvk,bhtk->bhtv', C, qc)
        den = jnp.sum(s, axis=-1) + sc * jnp.einsum('bhk,bhtk->bht', n, qc)
        h = num / jnp.maximum(jnp.abs(den), jnp.exp(-m_t))[..., None]
        bL = b[..., -1]
        g = bL[..., None] - b + igc
        m_new = jnp.maximum(bL + m, jnp.max(g, axis=-1))
        decay = jnp.exp(bL + m - m_new)
        wg = jnp.exp(g - m_new[..., None])
        C = decay[..., None, None] * C + jnp.einsum('bhs,bhsv,bhsk->bhvk', wg, vc, kc)
        n = decay[..., None] * n + jnp.einsum('bhs,bhsk->bhk', wg, kc)
        return (C, n, m_new), h

    init = (jnp.zeros((B, H, Dh, Dh), jnp.float32),
            jnp.zeros((B, H, Dh), jnp.float32),
            jnp.zeros((B, H), jnp.float32))
    _, hs = lax.scan(step, init, (to_chunks(q), to_chunks(k), to_chunks(v), to_chunks(ig), to_chunks(lf)))
    return jnp.moveaxis(hs, 0, 2).reshape(B, H, S, Dh)


def mlstm_group(q_pre, k_pre, v, o_pre, i_pre, f_pre, conv_w, conv_b, b_igate, b_fgate, norm_g):
    B, S, _ = q_pre.shape
    qk = jax.nn.silu(causal_conv(jnp.concatenate([q_pre, k_pre], axis=-1), conv_w, conv_b))
    q, k = qk[..., :MLSTM_WIDTH], qk[..., MLSTM_WIDTH:]

    def heads(a):
        return a.reshape(B, S, MLSTM_HEADS, MLSTM_HEAD_DIM).transpose(0, 2, 1, 3).astype(jnp.float32)

    ig = (i_pre + b_igate).astype(jnp.float32).transpose(0, 2, 1)
    lf = jax.nn.log_sigmoid((f_pre + b_fgate).astype(jnp.float32)).transpose(0, 2, 1)
    h = mlstm_chunkwise(heads(q), heads(k) * (MLSTM_HEAD_DIM ** -0.5), heads(v), ig, lf)
    h = h * lax.rsqrt(jnp.mean(h * h, axis=-1, keepdims=True) + EPS)
    h = h.transpose(0, 2, 1, 3).reshape(B, S, MLSTM_WIDTH) * norm_g.astype(jnp.float32)
    return (h * jax.nn.sigmoid(o_pre.astype(jnp.float32))).astype(q_pre.dtype)


def gmlp_group(u_pre, v_pre, ln_g, ln_b, w_s, b_s):
    B, S, _ = u_pre.shape
    u = jax.nn.gelu(u_pre)
    vv = jax.nn.gelu(v_pre).reshape(B, S, GMLP_GROUPS, GMLP_GROUP_DIM).astype(jnp.float32)
    mu = jnp.mean(vv, axis=-1, keepdims=True)
    var = jnp.mean(jnp.square(vv - mu), axis=-1, keepdims=True)
    vv = (vv - mu) * lax.rsqrt(var + EPS)
    vv = vv * ln_g.reshape(GMLP_GROUPS, GMLP_GROUP_DIM) + ln_b.reshape(GMLP_GROUPS, GMLP_GROUP_DIM)
    vv = vv.astype(u_pre.dtype).reshape(B, S // GMLP_CHUNK, GMLP_CHUNK, GMLP_GROUPS, GMLP_GROUP_DIM)
    pos = jnp.arange(GMLP_CHUNK) // CHUNK
    mask = (pos[:, None] >= pos[None, :]).astype(w_s.dtype)
    mix = jnp.einsum('gts,bcsgd->bctgd', w_s * mask, vv) + b_s.T[:, :, None]
    return u * mix.reshape(B, S, GMLP_WIDTH)


def peer(x, w_query, sub_keys, expert_u, expert_v):
    B, S, D = x.shape
    T = B * S
    xt = x.reshape(T, D)
    q = (xt @ w_query).reshape(T, PEER_HEADS, 2, PEER_HALF)
    s = jnp.einsum('thpd,hpkd->thpk', q, sub_keys).astype(jnp.float32)
    s1, i1 = lax.top_k(s[:, :, 0], PEER_TOPK)
    s2, i2 = lax.top_k(s[:, :, 1], PEER_TOPK)
    cand = (s1[..., :, None] + s2[..., None, :]).reshape(T, PEER_HEADS, PEER_TOPK * PEER_TOPK)
    cand_idx = (i1[..., :, None] * PEER_KEYS + i2[..., None, :]).reshape(T, PEER_HEADS, PEER_TOPK * PEER_TOPK)
    top_s, pos = lax.top_k(cand, PEER_TOPK)
    idx = jnp.take_along_axis(cand_idx, pos, axis=-1)
    gate = jax.nn.softmax(top_s, axis=-1).astype(x.dtype)
    nb = T // PEER_BLOCK

    def block(args):
        xb, ib, gb = args
        ub = jnp.take(expert_u, ib, axis=0)
        vb = jnp.take(expert_v, ib, axis=0)
        a = jax.nn.gelu(jnp.einsum('td,thkd->thk', xb, ub))
        return jnp.einsum('thk,thkd->td', a * gb, vb)

    out = lax.map(block, (xt.reshape(nb, PEER_BLOCK, D),
                          idx.reshape(nb, PEER_BLOCK, PEER_HEADS, PEER_TOPK),
                          gate.reshape(nb, PEER_BLOCK, PEER_HEADS, PEER_TOPK)))
    return out.reshape(B, S, D)


def setup_inputs(seed: int = 0) -> dict:
    key = jax.random.key(seed)
    ks = jax.random.split(key, 20)
    f32 = jnp.float32
    L = DEPTH
    nrm = lambda k, shape, scale: jax.random.normal(k, shape, f32) * scale
    return {
        "x": nrm(ks[0], (BATCH, SEQ, D_MODEL), 1.0),
        "norm1_g": 1.0 + nrm(ks[1], (L, D_MODEL), 0.02),
        "w_in": nrm(ks[2], (L, D_MODEL, D_IN_PROJ), D_MODEL ** -0.5),
        "conv_w": nrm(ks[3], (L, CONV_WIDTH, 2 * MLSTM_WIDTH), CONV_WIDTH ** -0.5),
        "conv_b": nrm(ks[4], (L, 2 * MLSTM_WIDTH), 0.02),
        "b_igate": nrm(ks[5], (L, MLSTM_HEADS), 0.1),
        "b_fgate": jnp.broadcast_to(jnp.linspace(3.0, 6.0, MLSTM_HEADS, dtype=f32), (L, MLSTM_HEADS)) + nrm(ks[6], (L, MLSTM_HEADS), 0.1),
        "mlstm_norm_g": 1.0 + nrm(ks[7], (L, MLSTM_WIDTH), 0.02),
        "gmlp_ln_g": 1.0 + nrm(ks[8], (L, GMLP_WIDTH), 0.02),
        "gmlp_ln_b": nrm(ks[9], (L, GMLP_WIDTH), 0.02),
        "gmlp_w_s": nrm(ks[10], (L, GMLP_GROUPS, GMLP_CHUNK, GMLP_CHUNK), GMLP_CHUNK ** -0.5),
        "gmlp_b_s": 1.0 + nrm(ks[11], (L, GMLP_GROUPS, GMLP_CHUNK), 0.02),
        "w_out": nrm(ks[12], (L, D_MIX, D_MODEL), D_MIX ** -0.5),
        "norm2_g": 1.0 + nrm(ks[13], (L, D_MODEL), 0.02),
        "peer_w_query": nrm(ks[14], (L, D_MODEL, PEER_HEADS * PEER_QUERY_DIM), D_MODEL ** -0.5),
        "peer_sub_keys": nrm(ks[15], (L, PEER_HEADS, 2, PEER_KEYS, PEER_HALF), PEER_HALF ** -0.5),
        "peer_u": nrm(ks[16], (L, PEER_EXPERTS, D_MODEL), D_MODEL ** -0.5),
        "peer_v": nrm(ks[17], (L, PEER_EXPERTS, D_MODEL), PEER_HEADS ** -0.5),
        "final_g": 1.0 + nrm(ks[18], (D_MODEL,), 0.02),
    }


def reference(x, norm1_g, w_in, conv_w, conv_b, b_igate, b_fgate, mlstm_norm_g,
              gmlp_ln_g, gmlp_ln_b, gmlp_w_s, gmlp_b_s, w_out, norm2_g,
              peer_w_query, peer_sub_keys, peer_u, peer_v, final_g):
    W = MLSTM_WIDTH
    for l in range(DEPTH):
        h = rmsnorm(x, norm1_g[l])
        z = h @ w_in[l]
        q_pre = z[..., 0:W]
        k_pre = z[..., W:2 * W]
        v = z[..., 2 * W:3 * W]
        o_pre = z[..., 3 * W:4 * W]
        g0 = 4 * W
        i_pre = z[..., g0:g0 + MLSTM_HEADS]
        f_pre = z[..., g0 + MLSTM_HEADS:g0 + 2 * MLSTM_HEADS]
        u0 = g0 + 2 * MLSTM_HEADS
        u_pre = z[..., u0:u0 + GMLP_WIDTH]
        vg_pre = z[..., u0 + GMLP_WIDTH:u0 + 2 * GMLP_WIDTH]
        y_a = mlstm_group(q_pre, k_pre, v, o_pre, i_pre, f_pre, conv_w[l], conv_b[l],
                          b_igate[l], b_fgate[l], mlstm_norm_g[l])
        y_b = gmlp_group(u_pre, vg_pre, gmlp_ln_g[l], gmlp_ln_b[l], gmlp_w_s[l], gmlp_b_s[l])
        x = x + jnp.concatenate([y_a, y_b], axis=-1) @ w_out[l]
        x = x + peer(rmsnorm(x, norm2_g[l]), peer_w_query[l], peer_sub_keys[l], peer_u[l], peer_v[l])
    return rmsnorm(x, final_g)
```

```cpp
#include <hip/hip_runtime.h>
#include <cstdio>
#include <cstdint>

#ifndef MK_N_LAUNCHES
#define MK_N_LAUNCHES 9
#endif

#define LAS __attribute__((address_space(3)))
#define GAS __attribute__((address_space(1)))
typedef unsigned short bf16;
typedef short bf16x8 __attribute__((ext_vector_type(8)));
typedef float f32x4 __attribute__((ext_vector_type(4)));
typedef float f32x2 __attribute__((ext_vector_type(2)));
typedef unsigned u32x4 __attribute__((ext_vector_type(4)));
typedef unsigned u32x2 __attribute__((ext_vector_type(2)));

namespace pg8 {
typedef unsigned short bf16_t;
constexpr int BM = 256, BK = 64, HALF = 128, HTB = HALF * BK * 2, STAGE_BYTES = 8 * HTB, NXCD = 8, WGM = 8;
__host__ __device__ __forceinline__ int lds_byte(int r, int c) { const int st = (r >> 4) * 2 + (c >> 5), rr = r & 15, cc = c & 31, ob = rr * 64 + cc * 2; return st * 1024 + (ob ^ (((ob >> 9) & 1) << 5)); }
__host__ __device__ __forceinline__ void stage_rc(int b, int& R, int& C) { const int st = b / 1024, sb = b % 1024, swz = sb ^ (((sb >> 9) & 1) << 5); R = (st >> 1) * 16 + swz / 64; C = (st & 1) * 32 + (swz % 64) / 2; }
__host__ __device__ __forceinline__ int perm32(int rho) { const int n = rho >> 4, i = rho & 15; return 8 * (i >> 2) + 4 * n + (i & 3); }
struct Unit { int pm, pn; };
struct Gemm { const bf16_t* A; const bf16_t* Bt; int M, N, K; };
struct StaticOrder {
    int nM, nN, nwg, G, c;
    __host__ __device__ void init(int M, int N, int G_, int c_) { nM = M / BM; nN = N / BM; nwg = nM * nN; G = G_; c = c_; }
    __host__ __device__ bool next(int i, Unit& u) const {
        const long L = (long)i * G + c; if (L >= nwg) return false;
        int wgid = (int)L; { const int q = nwg / NXCD, r = nwg % NXCD, xcd = wgid % NXCD, off = wgid / NXCD; wgid = (xcd < r ? xcd * (q + 1) : r * (q + 1) + (xcd - r) * q) + off; }
        const int nig = WGM * nN, gid = wgid / nig, fm = gid * WGM, gsz = (nM - fm) < WGM ? (nM - fm) : WGM;
        u.pm = fm + ((wgid % nig) % gsz); u.pn = (wgid % nig) / gsz; return true;
    }
    __device__ __forceinline__ void a_ready(const Unit&) const {}
    __device__ __forceinline__ void done(const Unit&) const {}
};
typedef __bf16 bf16x2_t __attribute__((ext_vector_type(2)));
__device__ __forceinline__ unsigned cvt_pk_bf16(float lo, float hi) { const f32x2 v = {lo, hi}; const bf16x2_t b = __builtin_convertvector(v, bf16x2_t); return __builtin_bit_cast(unsigned, b); }

template <class Epi, class Sched, bool ALIGN_EPI = false, bool SP2 = false>
__device__ __forceinline__ void gemm_phase(LAS unsigned char* lds, const Gemm g, const Sched& S, const Epi& E) {
    const int tid = threadIdx.x, wid = __builtin_amdgcn_readfirstlane(tid >> 6), lane = tid & 63, wr = wid >> 2, wc = wid & 3, fr = lane & 15, fq = lane >> 4;
    const int K = g.K, nt = K / BK;
    unsigned voffA[2], voffB[2];
#pragma unroll
    for (int i = 0; i < 2; ++i) { int R, C; stage_rc(tid * 16 + i * 8192, R, C); const int Rb = Epi::PERM ? ((R & ~31) + perm32(R & 31)) : R;
        voffA[i] = (unsigned)(R * K + C) * 2u; voffB[i] = (unsigned)(Rb * K + C) * 2u; }
    const size_t kstep = (size_t)(BK * 2);
    const size_t hstep = (size_t)HALF * K * 2;
    const size_t tstep = 2 * hstep;
    const unsigned ldsw = (unsigned)wid * 1024u;
    const int aoff = lds_byte(wr * 64 + fr, fq * 8), boff = lds_byte(wc * 32 + fr, fq * 8);
#define PG8_SA(b, h) (((b) * 2 + (h)) * HTB)
#define PG8_SB(b, h) ((4 + (b) * 2 + (h)) * HTB)
#define PG8_STAGE(bufoff, gbase, voff) do { _Pragma("unroll") for (int _i = 0; _i < 2; ++_i) \
        __builtin_amdgcn_global_load_lds((const unsigned*)((const char*)(gbase) + (voff)[_i]), (LAS unsigned*)(lds + (bufoff) + ldsw + _i * 8192), 16, 0, 0); } while (0)
#define PG8_LDA(dst, b, h) do { _Pragma("unroll") for (int m = 0; m < 4; ++m) _Pragma("unroll") for (int k = 0; k < 2; ++k) dst[m][k] = *(const LAS bf16x8*)(lds + PG8_SA(b, h) + aoff + m * 2048 + k * 1024); } while (0)
#define PG8_LDB(dst, b, h) do { _Pragma("unroll") for (int n = 0; n < 2; ++n) _Pragma("unroll") for (int k = 0; k < 2; ++k) dst[n][k] = *(const LAS bf16x8*)(lds + PG8_SB(b, h) + boff + n * 2048 + k * 1024); } while (0)
#define PG8_MMA(ai, bj, At, Bt) do { __builtin_amdgcn_s_setprio(1); _Pragma("unroll") for (int m = 0; m < 4; ++m) _Pragma("unroll") for (int n = 0; n < 2; ++n) _Pragma("unroll") for (int k = 0; k < 2; ++k) \
        acc[ai][bj][m][n] = __builtin_amdgcn_mfma_f32_16x16x32_bf16(Bt[n][k], At[m][k], acc[ai][bj][m][n], 0, 0, 0); __builtin_amdgcn_s_setprio(0); } while (0)
#define PG8_WAIT_V(n) asm volatile("s_waitcnt vmcnt(" #n ")" ::: "memory")
#define PG8_WAIT_L(n) asm volatile("s_waitcnt lgkmcnt(" #n ")" ::: "memory")
#define PG8_BAR __builtin_amdgcn_s_barrier()
#define PG8_SCHED __builtin_amdgcn_sched_barrier(0)
    Unit cur, nxt; int ui = 0;
    if (!S.next(0, cur)) return;
    f32x4 acc[2][2][4][2];
#pragma unroll
    for (int a = 0; a < 2; ++a)
#pragma unroll
        for (int b = 0; b < 2; ++b)
#pragma unroll
            for (int m = 0; m < 4; ++m)
#pragma unroll
                for (int n = 0; n < 2; ++n) acc[a][b][m][n] = (f32x4){0.f, 0.f, 0.f, 0.f};
    bf16x8 At[4][2], B0[2][2], B1[2][2];
    const char* cA = (const char*)g.A + (size_t)cur.pm * tstep; const char* cB = (const char*)g.Bt + (size_t)cur.pn * tstep;
    S.a_ready(cur);
    if constexpr (SP2) {
        PG8_STAGE(PG8_SB(0, 0), cB, voffB); PG8_STAGE(PG8_SB(0, 1), cB + hstep, voffB); PG8_STAGE(PG8_SA(0, 0), cA, voffA); PG8_STAGE(PG8_SA(0, 1), cA + hstep, voffA);
        if (wr == 1) PG8_BAR;
        PG8_WAIT_V(2); PG8_BAR;
        PG8_STAGE(PG8_SB(1, 0), cB + kstep, voffB); PG8_STAGE(PG8_SA(1, 0), cA + kstep, voffA); PG8_STAGE(PG8_SB(1, 1), cB + hstep + kstep, voffB);
        PG8_WAIT_V(6); PG8_BAR;
    } else {
        PG8_STAGE(PG8_SB(0, 0), cB, voffB); PG8_STAGE(PG8_SA(0, 0), cA, voffA); PG8_STAGE(PG8_SB(0, 1), cB + hstep, voffB); PG8_STAGE(PG8_SA(0, 1), cA + hstep, voffA);
        if (wr == 1) PG8_BAR;
        PG8_WAIT_V(4); PG8_BAR;
        PG8_STAGE(PG8_SB(1, 0), cB + kstep, voffB); PG8_STAGE(PG8_SA(1, 0), cA + kstep, voffA); PG8_STAGE(PG8_SB(1, 1), cB + hstep + kstep, voffB);
        PG8_WAIT_V(6); PG8_BAR;
    }
    for (;;) {
        const bool has_next = S.next(ui + 1, nxt);
        const char* nA = has_next ? (const char*)g.A + (size_t)nxt.pm * tstep : cA; const char* nB = has_next ? (const char*)g.Bt + (size_t)nxt.pn * tstep : cB;
        for (int t = 0; t < nt; t += 2) {
            const bool last = (t == nt - 2);
            const char* a1 = cA + (size_t)(t + 1) * kstep;
            const char* a2 = last ? nA : cA + (size_t)(t + 2) * kstep; const char* b2 = last ? nB : cB + (size_t)(t + 2) * kstep;
            const char* a3 = a2 + kstep; const char* b3 = b2 + kstep;
            if (last && has_next) S.a_ready(nxt);
            if constexpr (SP2) {
            PG8_LDB(B0, 0, 0); PG8_LDB(B1, 0, 1); PG8_SCHED; PG8_LDA(At, 0, 0); PG8_STAGE(PG8_SA(1, 1), a1 + hstep, voffA);
            PG8_WAIT_V(8); PG8_WAIT_L(0); PG8_BAR; PG8_MMA(0, 0, At, B0); PG8_MMA(0, 1, At, B1); PG8_BAR; PG8_SCHED;
            PG8_LDA(At, 0, 1); PG8_STAGE(PG8_SB(0, 0), b2, voffB); PG8_STAGE(PG8_SB(0, 1), b2 + hstep, voffB); PG8_STAGE(PG8_SA(0, 0), a2, voffA);
            PG8_WAIT_V(8); PG8_WAIT_L(0); PG8_BAR; PG8_MMA(1, 0, At, B0); PG8_MMA(1, 1, At, B1); PG8_BAR; PG8_SCHED;
            PG8_LDB(B0, 1, 0); PG8_LDB(B1, 1, 1); PG8_SCHED; PG8_LDA(At, 1, 0); PG8_STAGE(PG8_SA(0, 1), a2 + hstep, voffA);
            PG8_WAIT_V(8); PG8_WAIT_L(0); PG8_BAR; PG8_MMA(0, 0, At, B0); PG8_MMA(0, 1, At, B1); PG8_BAR; PG8_SCHED;
            PG8_LDA(At, 1, 1); PG8_STAGE(PG8_SB(1, 0), b3, voffB); PG8_STAGE(PG8_SB(1, 1), b3 + hstep, voffB); PG8_STAGE(PG8_SA(1, 0), a3, voffA);
            PG8_WAIT_V(8); PG8_WAIT_L(0); PG8_BAR; PG8_MMA(1, 0, At, B0); PG8_MMA(1, 1, At, B1); PG8_BAR; PG8_SCHED;
            } else {
            PG8_LDB(B0, 0, 0); PG8_SCHED; PG8_LDA(At, 0, 0); PG8_STAGE(PG8_SA(1, 1), a1 + hstep, voffA);
            PG8_WAIT_L(8); PG8_BAR; PG8_WAIT_L(0); PG8_MMA(0, 0, At, B0); PG8_BAR; PG8_SCHED;
            PG8_LDB(B1, 0, 1); PG8_STAGE(PG8_SB(0, 0), b2, voffB);
            PG8_BAR; PG8_WAIT_L(0); PG8_MMA(0, 1, At, B1); PG8_BAR;
            PG8_LDA(At, 0, 1); PG8_STAGE(PG8_SA(0, 0), a2, voffA);
            PG8_BAR; PG8_WAIT_L(0); PG8_MMA(1, 0, At, B0); PG8_BAR; PG8_SCHED;
            PG8_STAGE(PG8_SB(0, 1), b2 + hstep, voffB);
            PG8_WAIT_V(6); PG8_BAR; PG8_MMA(1, 1, At, B1); PG8_BAR;
            PG8_LDB(B0, 1, 0); PG8_SCHED; PG8_LDA(At, 1, 0); PG8_STAGE(PG8_SA(0, 1), a2 + hstep, voffA);
            PG8_WAIT_L(8); PG8_BAR; PG8_WAIT_L(0); PG8_MMA(0, 0, At, B0); PG8_BAR; PG8_SCHED;
            PG8_LDB(B1, 1, 1); PG8_STAGE(PG8_SB(1, 0), b3, voffB);
            PG8_BAR; PG8_WAIT_L(0); PG8_MMA(0, 1, At, B1); PG8_BAR;
            PG8_LDA(At, 1, 1); PG8_STAGE(PG8_SA(1, 0), a3, voffA);
            PG8_BAR; PG8_WAIT_L(0); PG8_MMA(1, 0, At, B0); PG8_BAR; PG8_SCHED;
            PG8_STAGE(PG8_SB(1, 1), b3 + hstep, voffB);
            PG8_WAIT_V(6); PG8_BAR; PG8_MMA(1, 1, At, B1); PG8_BAR;
            }
        }
        if constexpr (ALIGN_EPI) { if (wr == 0) PG8_BAR; }
        E(acc, cur, wr, wc, fr, fq);
        if (!has_next) break;
#pragma unroll
        for (int a = 0; a < 2; ++a)
#pragma unroll
            for (int b = 0; b < 2; ++b)
#pragma unroll
                for (int m = 0; m < 4; ++m)
#pragma unroll
                    for (int n = 0; n < 2; ++n) acc[a][b][m][n] = (f32x4){0.f, 0.f, 0.f, 0.f};
        cur = nxt; cA = nA; cB = nB; ++ui;
        if constexpr (ALIGN_EPI) { if (wr == 1) PG8_BAR; }
    }
    PG8_WAIT_V(0);
    if constexpr (!ALIGN_EPI) { if (wr == 0) PG8_BAR; }
    PG8_BAR;
#undef PG8_SA
#undef PG8_SB
#undef PG8_STAGE
#undef PG8_LDA
#undef PG8_LDB
#undef PG8_MMA
#undef PG8_WAIT_V
#undef PG8_WAIT_L
#undef PG8_BAR
#undef PG8_SCHED
}
}

constexpr int NWAVES = 8, NTHREADS = 512;
constexpr int BATCH = 4, SEQ = 4096, DM = 1024, T = BATCH * SEQ;
constexpr int NH = 4, DH = 128, MW = 512, NIN = 3080, NZ = 3072, NBH = BATCH * NH, NCH = SEQ / 64;
constexpr int PH = 8, PKEYS = 128, PQD = 256, TOPK = 16, NEXP = 16384;
constexpr float EPS = 1e-6f;
constexpr int NPHASE = 9;
constexpr int N_LAUNCHES = MK_N_LAUNCHES;

constexpr size_t MiB = 1u << 20;
constexpr size_t WS_CTL = 0, CTL_ZERO_BYTES = 1 * MiB;
constexpr size_t WS_SUMSQ2 = 128 * 1024;
constexpr size_t WS_RS1 = 1 * MiB;
constexpr size_t WS_LF = WS_RS1 + (size_t)T * 4;
constexpr size_t WS_IG = WS_LF + (size_t)NBH * SEQ * 4;
constexpr size_t WS_BC = WS_IG + (size_t)NBH * SEQ * 4;
constexpr size_t WS_AV = WS_BC + (size_t)NBH * SEQ * 4;
constexpr size_t WS_BL = WS_AV + (size_t)NBH * SEQ * 4;
constexpr size_t WS_AM = WS_BL + (size_t)NBH * NCH * 4;
constexpr size_t WS_DN = WS_AM + (size_t)NBH * NCH * 4;
constexpr size_t WS_NP = WS_DN + (size_t)NBH * NCH * DH * 4;
constexpr size_t WS_SMALL_END = WS_NP + (size_t)NBH * NCH * DH * 4;
constexpr size_t WS_W1T = 4 * MiB, WS_WOT = 10 * MiB, WS_WQT = 12 * MiB, WS_SKB = 16 * MiB;
constexpr size_t WS_XB = 17 * MiB, WS_Y = WS_XB;
constexpr size_t WS_XB1 = 49 * MiB;
constexpr size_t WS_Z = 81 * MiB;
constexpr size_t WS_Q = WS_Z, WS_IDX = WS_Z + 64 * MiB, WS_GATE = WS_Z + 72 * MiB;
constexpr size_t WS_DC = 177 * MiB, WS_UB = WS_DC;
constexpr size_t WS_CP = 209 * MiB, WS_VB = WS_CP;
constexpr size_t WS_SSP = 241 * MiB;
constexpr size_t WS_END = 242 * MiB;
static_assert(WS_SMALL_END <= WS_W1T && WS_SKB + 512 * 1024 <= WS_XB, "ws map");
constexpr int CW_TMO = 0, CW_CODE = 1, CW_BAR = 4096;

constexpr int LDS_BYTES = 147456, LDSCTL_OFF = LDS_BYTES - 256;

typedef GAS unsigned gu32;
#define RLX_AGENT __ATOMIC_RELAXED, __HIP_MEMORY_SCOPE_AGENT
#define LDS_WAIT() asm volatile("s_waitcnt lgkmcnt(0)" ::: "memory")
__device__ __forceinline__ unsigned pk2(float lo, float hi) { return pg8::cvt_pk_bf16(lo, hi); }
__device__ __forceinline__ float bf2f(unsigned short b) { return __uint_as_float((unsigned)b << 16); }
__device__ __forceinline__ float bflo(unsigned w) { return __uint_as_float(w << 16); }
__device__ __forceinline__ float bfhi(unsigned w) { return __uint_as_float(w & 0xffff0000u); }
__device__ __forceinline__ float wave_sum(float v) {
#pragma unroll
    for (int o = 1; o < 64; o <<= 1) v += __shfl_xor(v, o);
    return v;
}
__device__ __forceinline__ float wave_max(float v) {
#pragma unroll
    for (int o = 1; o < 64; o <<= 1) v = fmaxf(v, __shfl_xor(v, o));
    return v;
}
__device__ __forceinline__ float sigmoidf_(float x) { return __builtin_amdgcn_rcpf(1.f + __expf(-x)); }
__device__ __forceinline__ float siluf_(float x) { return x * sigmoidf_(x); }
__device__ __forceinline__ float gelu_tanh(float x) { const float u = 1.5957691216057308f * (x + 0.044715f * x * x * x); return x * sigmoidf_(u); }

#define XB_TMO      128
#define XB_XCNT(j)  (256  + 64 * (j))
#define XB_XSUB(j)  (1280 + 64 * (j))
#define XB_XGEN(j)  (2304 + 64 * (j))
#define XB_TOP      3328
#define XB_TOPGEN   3392
#define XCD_BAR_WORDS 3456
#define XB_SPIN_CAP (1u << 18)
__device__ __forceinline__ unsigned xb_ld(unsigned* p)              { return __hip_atomic_load(p, __ATOMIC_RELAXED, __HIP_MEMORY_SCOPE_AGENT); }
__device__ __forceinline__ unsigned xb_add(unsigned* p, unsigned v) { return __hip_atomic_fetch_add(p, v, __ATOMIC_RELAXED, __HIP_MEMORY_SCOPE_AGENT); }
__device__ __forceinline__ unsigned xb_xcc_id() { return (unsigned)__builtin_amdgcn_s_getreg((3 << 11) | 20) & 0xFu; }
#define XB_SPIN(cond, bar) do { unsigned _sp = 0; while (cond) { __builtin_amdgcn_s_sleep(1); \
    if ((++_sp & 255u) == 0u) { if (xb_ld(&(bar)[XB_TMO])) break; if (_sp > XB_SPIN_CAP) { atomicAdd(&(bar)[XB_TMO], 1u); break; } } } } while (0)
struct XcdBarrier { unsigned* bar; unsigned x; volatile LAS unsigned* st; };
__device__ __forceinline__ XcdBarrier xcd_barrier_post(unsigned* bar, volatile LAS unsigned* st) {
    XcdBarrier b; b.bar = bar; b.x = xb_xcc_id(); b.st = st;
    if (threadIdx.x == 0) (void)xb_add(&bar[XB_XCNT(b.x)], 1u);
    return b;
}
__device__ __forceinline__ void xcd_barrier_complete(unsigned* bar, unsigned x, unsigned& nloc, unsigned& nx) {
    const unsigned G = gridDim.x * gridDim.y * gridDim.z;
    unsigned sum, cnt, mine, sp = 0u;
    for (;;) {
        sum = 0u; cnt = 0u; mine = 0u;
#pragma unroll
        for (unsigned j = 0; j < 16; ++j) { const unsigned c = xb_ld(&bar[XB_XCNT(j)]); sum += c; cnt += (c > 0u) ? 1u : 0u; mine = (j == x) ? c : mine; }
        if (sum == G) break;
        __builtin_amdgcn_s_sleep(1);
        if ((++sp & 255u) == 0u) { if (xb_ld(&bar[XB_TMO])) break; if (sp > XB_SPIN_CAP) { atomicAdd(&bar[XB_TMO], 1u); break; } }
    }
    nloc = mine > 0u ? mine : 1u; nx = cnt > 0u ? cnt : 1u;
}
__device__ __forceinline__ void xcd_barrier(const XcdBarrier& b) {
    asm volatile("s_waitcnt vmcnt(0)" ::: "memory");
    __syncthreads();
    if (threadIdx.x == 0) {
        unsigned* bar = b.bar;
        __builtin_amdgcn_s_waitcnt(0);
        unsigned nloc = b.st[0], nx = b.st[1];
        if (nloc == 0u) { xcd_barrier_complete(bar, b.x, nloc, nx); b.st[0] = nloc; b.st[1] = nx; }
        const unsigned old = xb_add(&bar[XB_XSUB(b.x)], 1u);
        const unsigned gen = old / nloc;
        if (old + 1u == (gen + 1u) * nloc) {
            __builtin_amdgcn_fence(__ATOMIC_RELEASE, "agent");
            asm volatile("s_waitcnt vmcnt(0)" ::: "memory");
            const unsigned og = xb_add(&bar[XB_TOP], 1u);
            const unsigned tg = og / nx;
            if (og + 1u == (tg + 1u) * nx) xb_add(&bar[XB_TOPGEN], 1u);
            else XB_SPIN(xb_ld(&bar[XB_TOPGEN]) == tg, bar);
            __builtin_amdgcn_fence(__ATOMIC_ACQUIRE, "agent");
            xb_add(&bar[XB_XGEN(b.x)], 1u);
            asm volatile("s_waitcnt vmcnt(0)" ::: "memory");
        } else {
            XB_SPIN(xb_ld(&bar[XB_XGEN(b.x)]) == gen, bar);
            __builtin_amdgcn_fence(__ATOMIC_ACQUIRE, "agent");
            asm volatile("s_waitcnt vmcnt(0)" ::: "memory");
        }
    }
    __syncthreads();
}

__device__ __forceinline__ bf16x8 ldfrag(const LAS bf16* img, int ld, int i0, int k0, int lane) {
    return *(const LAS bf16x8*)(img + (i0 + (lane & 15)) * ld + k0 + 8 * (lane >> 4));
}
__device__ __forceinline__ bf16x8 ldfragT(const LAS bf16* img, int ld, int i0, int k0, int lane) {
    const LAS bf16* p = img + (k0 + 8 * (lane >> 4)) * ld + i0 + (lane & 15);
    bf16x8 r;
#pragma unroll
    for (int j = 0; j < 8; ++j) r[j] = (short)p[j * ld];
    return r;
}
#define MMA16(nf, mf, acc) __builtin_amdgcn_mfma_f32_16x16x32_bf16(nf, mf, acc, 0, 0, 0)

__device__ __forceinline__ float row_rs2(const float* ssp, int r) {
    const f32x4* p = (const f32x4*)(ssp + (size_t)r * 16); const f32x4 a = p[0], b = p[1], c = p[2], d = p[3];
    const float s = (((a[0] + a[1]) + (a[2] + a[3])) + ((b[0] + b[1]) + (b[2] + b[3]))) + (((c[0] + c[1]) + (c[2] + c[3])) + ((d[0] + d[1]) + (d[2] + d[3])));
    return rsqrtf(s * (1.f / 1024.f) + 1e-6f);
}
typedef pg8::Unit Unit;
struct EpiZ {
    static constexpr bool PERM = true;
    bf16* O; int ldc; const float* rs; int act_pn;
    __device__ __forceinline__ void operator()(const f32x4 (&acc)[2][2][4][2], const Unit& u, int wr, int wc, int fr, int fq) const {
        const int row0 = u.pm * 256 + wr * 64 + fr, col0 = u.pn * 256 + wc * 32 + 8 * fq; const bool act = u.pn >= act_pn;
#pragma unroll
        for (int ai = 0; ai < 2; ++ai)
#pragma unroll
            for (int m = 0; m < 4; ++m) { const int r = row0 + ai * 128 + m * 16; const float s = rs[r]; bf16* rowp = O + (size_t)r * ldc + col0;
#pragma unroll
                for (int bj = 0; bj < 2; ++bj) { f32x4 v0 = acc[ai][bj][m][0] * s, v1 = acc[ai][bj][m][1] * s;
                    if (act) {
#pragma unroll
                        for (int e = 0; e < 4; ++e) { v0[e] = gelu_tanh(v0[e]); v1[e] = gelu_tanh(v1[e]); } }
                    u32x4 w; w.x = pk2(v0[0], v0[1]); w.y = pk2(v0[2], v0[3]); w.z = pk2(v1[0], v1[1]); w.w = pk2(v1[2], v1[3]);
                    *(u32x4*)(rowp + bj * 128) = w; } }
    }
};
struct EpiQ {
    static constexpr bool PERM = true;
    bf16* O; int ldc; const float* sumsq;
    __device__ __forceinline__ void operator()(const f32x4 (&acc)[2][2][4][2], const Unit& u, int wr, int wc, int fr, int fq) const {
        const int row0 = u.pm * 256 + wr * 64 + fr, col0 = u.pn * 256 + wc * 32 + 8 * fq;
#pragma unroll
        for (int ai = 0; ai < 2; ++ai)
#pragma unroll
            for (int m = 0; m < 4; ++m) { const int r = row0 + ai * 128 + m * 16; const float s = row_rs2(sumsq, r); bf16* rowp = O + (size_t)r * ldc + col0;
#pragma unroll
                for (int bj = 0; bj < 2; ++bj) { const f32x4 v0 = acc[ai][bj][m][0] * s, v1 = acc[ai][bj][m][1] * s;
                    u32x4 w; w.x = pk2(v0[0], v0[1]); w.y = pk2(v0[2], v0[3]); w.z = pk2(v1[0], v1[1]); w.w = pk2(v1[2], v1[3]);
                    *(u32x4*)(rowp + bj * 128) = w; } }
    }
};
struct EpiX1 {
    static constexpr bool PERM = true;
    const float* X; float* X1; bf16* XB1; float* sumsq;
    __device__ __forceinline__ void operator()(const f32x4 (&acc)[2][2][4][2], const Unit& u, int wr, int wc, int fr, int fq) const {
        const int row0 = u.pm * 256 + wr * 64 + fr, col0 = u.pn * 256 + wc * 32 + 8 * fq;
#pragma unroll
        for (int ai = 0; ai < 2; ++ai)
#pragma unroll
            for (int m = 0; m < 4; ++m) { const int r = row0 + ai * 128 + m * 16; float ss = 0.f;
#pragma unroll
                for (int bj = 0; bj < 2; ++bj) { const size_t off = (size_t)r * DM + col0 + bj * 128;
                    const f32x4 xa = *(const f32x4*)(X + off), xb = *(const f32x4*)(X + off + 4);
                    const f32x4 v0 = acc[ai][bj][m][0] + xa, v1 = acc[ai][bj][m][1] + xb;
                    *(f32x4*)(X1 + off) = v0; *(f32x4*)(X1 + off + 4) = v1;
                    u32x4 w; w.x = pk2(v0[0], v0[1]); w.y = pk2(v0[2], v0[3]); w.z = pk2(v1[0], v1[1]); w.w = pk2(v1[2], v1[3]);
                    *(u32x4*)(XB1 + off) = w;
                    ss += (v0[0] * v0[0] + v0[1] * v0[1]) + (v0[2] * v0[2] + v0[3] * v0[3]) + (v1[0] * v1[0] + v1[1] * v1[1]) + (v1[2] * v1[2] + v1[3] * v1[3]); }
                ss += __shfl_xor(ss, 16); ss += __shfl_xor(ss, 32);
                if (fq == 0) sumsq[(size_t)r * 16 + u.pn * 4 + wc] = ss; }
    }
};

struct Args { const float* in[19]; float* out; unsigned char* ws; int ph_lo, ph_hi; };
enum { I_X = 0, I_G1, I_WIN, I_CW, I_CB, I_BI, I_BF, I_MNG, I_LNG, I_LNB, I_WS, I_BS, I_WOUT, I_G2, I_WQ, I_SK, I_PU, I_PV, I_GF };

__device__ __forceinline__ void transpose_item(const float* W, int ldsrc, int K, bf16* WT, const float* gk, LAS float* scr, int k0, int n0src, int n0dst, int lane) {
#pragma unroll 8
    for (int i = 0; i < 32; ++i) { const int kk = 2 * i + (lane >> 5); float w = W[(size_t)(k0 + kk) * ldsrc + n0src + (lane & 31)]; if (gk) w *= gk[k0 + kk]; scr[kk * 33 + (lane & 31)] = w; }
    LDS_WAIT(); asm volatile("" ::: "memory");
    const int c = lane & 7;
#pragma unroll
    for (int j = 0; j < 4; ++j) { const int n = (lane >> 3) + 8 * j; const LAS float* s = scr + (8 * c) * 33 + n;
        u32x4 o; o.x = pk2(s[0 * 33], s[1 * 33]); o.y = pk2(s[2 * 33], s[3 * 33]); o.z = pk2(s[4 * 33], s[5 * 33]); o.w = pk2(s[6 * 33], s[7 * 33]);
        *(u32x4*)(WT + (size_t)(n0dst + n) * K + k0 + 8 * c) = o; }
    LDS_WAIT(); asm volatile("" ::: "memory");
}
__device__ __forceinline__ float logsigmoidf_(float x) { return fminf(x, 0.f) - log1pf(__expf(-fabsf(x))); }

__device__ __forceinline__ void p0_prologue(const Args& a, LAS unsigned char* lds, int tid, int lane, int wave, int bid, int G) {
    unsigned char* ws = a.ws;
    const float* win = a.in[I_WIN]; const float* g1 = a.in[I_G1];
    LAS float* WgL = (LAS float*)lds;
    for (int idx = tid; idx < 8 * DM; idx += NTHREADS) { const int k = idx >> 3, c = idx & 7; WgL[c * DM + k] = win[(size_t)k * NIN + 2048 + c] * g1[k]; }
    __syncthreads();
    LAS float* scr = (LAS float*)(lds + 32768 + wave * 8448);
    const int gw = bid * NWAVES + wave, NGW = G * NWAVES;
    constexpr int I1 = 16 * 96, I2 = 16 * 32, I3 = 16 * 64;
    for (int it = gw; it < I1 + I2 + I3; it += NGW) {
        int r = it;
        if (r < I1) { const int kb = r / 96, nb = r % 96, n0 = 32 * nb; transpose_item(win, NIN, DM, (bf16*)(ws + WS_W1T), g1, scr, 64 * kb, n0 + (n0 >= 2048 ? 8 : 0), n0, lane); continue; } r -= I1;
        if (r < I2) { const int kb = r / 32, nb = r % 32; transpose_item(a.in[I_WOUT], DM, DM, (bf16*)(ws + WS_WOT), nullptr, scr, 64 * kb, 32 * nb, 32 * nb, lane); continue; } r -= I2;
        { const int kb = r / 64, nb = r % 64; transpose_item(a.in[I_WQ], 2048, DM, (bf16*)(ws + WS_WQT), a.in[I_G2], scr, 64 * kb, 32 * nb, 32 * nb, lane); }
    }
    { const f32x4* src = (const f32x4*)a.in[I_SK]; u32x2* dst = (u32x2*)(ws + WS_SKB);
      for (int i = bid * NTHREADS + tid; i < PH * 2 * PKEYS * 128 / 4; i += G * NTHREADS) { const f32x4 v = src[i]; u32x2 o; o.x = pk2(v[0], v[1]); o.y = pk2(v[2], v[3]); dst[i] = o; } }
    const float* x = a.in[I_X]; bf16* XB = (bf16*)(ws + WS_XB); float* rs1 = (float*)(ws + WS_RS1); float* LF = (float*)(ws + WS_LF); float* IG = (float*)(ws + WS_IG);
    const float* bi = a.in[I_BI]; const float* bfg = a.in[I_BF];
    for (int m = gw; m < T; m += NGW) {
        const f32x4* xr = (const f32x4*)(x + (size_t)m * DM) + lane;
        f32x4 v[4]; float ss = 0.f;
#pragma unroll
        for (int j = 0; j < 4; ++j) { v[j] = xr[64 * j]; ss += (v[j][0] * v[j][0] + v[j][1] * v[j][1]) + (v[j][2] * v[j][2] + v[j][3] * v[j][3]); }
        const float rs = rsqrtf(wave_sum(ss) * (1.f / DM) + EPS);
        u32x2* o8 = (u32x2*)(XB + (size_t)m * DM) + lane;
#pragma unroll
        for (int j = 0; j < 4; ++j) { u32x2 o; o.x = pk2(v[j][0], v[j][1]); o.y = pk2(v[j][2], v[j][3]); o8[64 * j] = o; }
        float gsel = 0.f;
#pragma unroll
        for (int c = 0; c < 8; ++c) { float p = 0.f;
#pragma unroll
            for (int j = 0; j < 4; ++j) { const f32x4 w = *(const LAS f32x4*)(WgL + c * DM + 256 * j + 4 * lane); p += (v[j][0] * w[0] + v[j][1] * w[1]) + (v[j][2] * w[2] + v[j][3] * w[3]); }
            p = wave_sum(p) * rs; if (lane == c) gsel = p; }
        const int b = m >> 12, s = m & (SEQ - 1);
        if (lane == 0) rs1[m] = rs;
        if (lane < 4) IG[(size_t)(b * NH + lane) * SEQ + s] = gsel + bi[lane];
        else if (lane < 8) LF[(size_t)(b * NH + lane - 4) * SEQ + s] = logsigmoidf_(gsel + bfg[lane - 4]);
    }
}

__device__ __forceinline__ void p1_stats(const Args& a, int lane, int gw) {
    if (gw >= NBH * NCH) return;
    unsigned char* ws = a.ws; const int bh = gw >> 6, c = gw & 63; const size_t o = (size_t)bh * SEQ + c * 64 + lane;
    float b = ((const float*)(ws + WS_LF))[o];
#pragma unroll
    for (int d = 1; d < 64; d <<= 1) { const float t = __shfl_up(b, d); if (lane >= d) b += t; }
    const float av = ((const float*)(ws + WS_IG))[o] - b;
    ((float*)(ws + WS_BC))[o] = b; ((float*)(ws + WS_AV))[o] = av;
    const float bL = __shfl(b, 63), am = wave_max(av);
    if (lane == 0) { ((float*)(ws + WS_BL))[gw] = bL; ((float*)(ws + WS_AM))[gw] = am; }
}
__device__ __forceinline__ float m_prev_of(const float* bL, const float* am, int bh, int c) {
    float m = 0.f;
    for (int j = 0; j < c; ++j) m = bL[bh * 64 + j] + fmaxf(m, am[bh * 64 + j]);
    return m;
}

__device__ __forceinline__ void conv2(const bf16* Z, const float* cw, const float* cb, int tok0, int sloc0, int r0, int ch0, float (&o)[2][8]) {
    float w[4][8], bias[8], xv[5][8];
#pragma unroll
    for (int j = 0; j < 4; ++j) { const f32x4 w0 = *(const f32x4*)(cw + j * 1024 + ch0), w1 = *(const f32x4*)(cw + j * 1024 + ch0 + 4);
#pragma unroll
        for (int e = 0; e < 4; ++e) { w[j][e] = w0[e]; w[j][4 + e] = w1[e]; } }
    { const f32x4 b0 = *(const f32x4*)(cb + ch0), b1 = *(const f32x4*)(cb + ch0 + 4);
#pragma unroll
      for (int e = 0; e < 4; ++e) { bias[e] = b0[e]; bias[4 + e] = b1[e]; } }
#pragma unroll
    for (int i = 0; i < 5; ++i) { const int sr = r0 - 3 + i; u32x4 q = (u32x4){0u, 0u, 0u, 0u};
        if (sloc0 + sr >= 0) q = *(const u32x4*)(Z + (size_t)(tok0 + sr) * NZ + ch0);
        xv[i][0] = bflo(q.x); xv[i][1] = bfhi(q.x); xv[i][2] = bflo(q.y); xv[i][3] = bfhi(q.y); xv[i][4] = bflo(q.z); xv[i][5] = bfhi(q.z); xv[i][6] = bflo(q.w); xv[i][7] = bfhi(q.w); }
#pragma unroll
    for (int r = 0; r < 2; ++r)
#pragma unroll
        for (int e = 0; e < 8; ++e) { float acc = bias[e];
#pragma unroll
            for (int j = 0; j < 4; ++j) acc += w[j][e] * xv[r + j][e];
            o[r][e] = siluf_(acc); }
}

__device__ __forceinline__ void p2_dc_task(const Args& a, LAS unsigned char* lds, int tid, int lane, int wave, int task) {
    unsigned char* ws = a.ws; const bf16* Z = (const bf16*)(ws + WS_Z);
    const int bh = task >> 6, c = task & 63, b = bh >> 2, h = bh & 3, tok0 = b * SEQ + c * 64;
    const float* AV = (const float*)(ws + WS_AV) + (size_t)bh * SEQ + c * 64;
    const float mp = m_prev_of((const float*)(ws + WS_BL), (const float*)(ws + WS_AM), bh, c);
    const float M63 = fmaxf(mp, ((const float*)(ws + WS_AM))[bh * 64 + c]);
    LAS bf16* KT = (LAS bf16*)lds; LAS bf16* VT = (LAS bf16*)(lds + 16640); LAS float* WG = (LAS float*)(lds + 33280);
    if (tid < 64) WG[tid] = __expf(AV[tid] - M63);
    const int cc = tid & 15, rp = tid >> 4, r0 = 2 * rp;
    { float o[2][8]; conv2(Z, a.in[I_CW], a.in[I_CB], tok0, c * 64, r0, 512 + h * DH + 8 * cc, o);
#pragma unroll
      for (int r = 0; r < 2; ++r) { LAS unsigned* d = (LAS unsigned*)(KT + (r0 + r) * 130 + 8 * cc);
#pragma unroll
          for (int e = 0; e < 4; ++e) d[e] = pk2(o[r][2 * e] * 0.08838834764831845f, o[r][2 * e + 1] * 0.08838834764831845f); } }
#pragma unroll
    for (int r = 0; r < 2; ++r) { const float wg = __expf(AV[r0 + r] - M63);
        const u32x4 q = *(const u32x4*)(Z + (size_t)(tok0 + r0 + r) * NZ + 1024 + h * DH + 8 * cc);
        LAS unsigned* d = (LAS unsigned*)(VT + (r0 + r) * 130 + 8 * cc);
        d[0] = pk2(bflo(q.x) * wg, bfhi(q.x) * wg); d[1] = pk2(bflo(q.y) * wg, bfhi(q.y) * wg); d[2] = pk2(bflo(q.z) * wg, bfhi(q.z) * wg); d[3] = pk2(bflo(q.w) * wg, bfhi(q.w) * wg); }
    __syncthreads();
    f32x4 acc[8];
#pragma unroll
    for (int n = 0; n < 8; ++n) acc[n] = (f32x4){0.f, 0.f, 0.f, 0.f};
#pragma unroll
    for (int kk = 0; kk < 2; ++kk) { const bf16x8 mf = ldfragT(VT, 130, 16 * wave, 32 * kk, lane);
#pragma unroll
        for (int n = 0; n < 8; ++n) { const bf16x8 nf = ldfragT(KT, 130, 16 * n, 32 * kk, lane); acc[n] = MMA16(nf, mf, acc[n]); } }
    bf16* DC = (bf16*)(ws + WS_DC) + ((size_t)task * DH + 16 * wave + (lane & 15)) * DH + 4 * (lane >> 4);
#pragma unroll
    for (int n = 0; n < 8; ++n) { u32x2 o; o.x = pk2(acc[n][0], acc[n][1]); o.y = pk2(acc[n][2], acc[n][3]); *(u32x2*)(DC + 16 * n) = o; }
    if (tid < DH) { float s = 0.f;
#pragma unroll 8
        for (int r = 0; r < 64; ++r) s += WG[r] * bf2f(KT[r * 130 + tid]);
        ((float*)(ws + WS_DN))[(size_t)task * DH + tid] = s; }
    __syncthreads();
}

__device__ __forceinline__ void p2_gmlp_task(const Args& a, LAS unsigned char* lds, int tid, int lane, int wave, int task) {
    unsigned char* ws = a.ws; const bf16* Z = (const bf16*)(ws + WS_Z); bf16* Y = (bf16*)(ws + WS_Y);
    const int g = task & 3, ck = (task >> 2) & 31, b = task >> 7, tok0 = b * SEQ + ck * 128;
    LAS bf16* VV = (LAS bf16*)lds; LAS bf16* WM = (LAS bf16*)(lds + 33280);
    { const int r = tid >> 2, qd = tid & 3; const bf16* src = Z + (size_t)(tok0 + r) * NZ + 2560 + g * 128 + 32 * qd; float v[32];
#pragma unroll
      for (int i = 0; i < 4; ++i) { const u32x4 q = *(const u32x4*)(src + 8 * i);
          v[8 * i + 0] = bflo(q.x); v[8 * i + 1] = bfhi(q.x); v[8 * i + 2] = bflo(q.y); v[8 * i + 3] = bfhi(q.y); v[8 * i + 4] = bflo(q.z); v[8 * i + 5] = bfhi(q.z); v[8 * i + 6] = bflo(q.w); v[8 * i + 7] = bfhi(q.w); }
      float s = 0.f;
#pragma unroll
      for (int i = 0; i < 32; ++i) s += v[i];
      s += __shfl_xor(s, 1); s += __shfl_xor(s, 2);
      const float mu = s * (1.f / 128.f); float q2 = 0.f;
#pragma unroll
      for (int i = 0; i < 32; ++i) { v[i] -= mu; q2 += v[i] * v[i]; }
      q2 += __shfl_xor(q2, 1); q2 += __shfl_xor(q2, 2);
      const float rstd = rsqrtf(q2 * (1.f / 128.f) + EPS);
      const float* lg = a.in[I_LNG] + g * 128 + 32 * qd; const float* lb = a.in[I_LNB] + g * 128 + 32 * qd;
      LAS unsigned* d = (LAS unsigned*)(VV + r * 130 + 32 * qd);
#pragma unroll
      for (int i = 0; i < 16; ++i) d[i] = pk2(v[2 * i] * rstd * lg[2 * i] + lb[2 * i], v[2 * i + 1] * rstd * lg[2 * i + 1] + lb[2 * i + 1]); }
    { const f32x4* wsrc = (const f32x4*)(a.in[I_WS] + (size_t)g * 128 * 128);
#pragma unroll
      for (int i = 0; i < 8; ++i) { const int idx = tid + NTHREADS * i, t = idx >> 5, s4 = (idx & 31) * 4; f32x4 w = wsrc[idx];
          if ((t >> 6) < (s4 >> 6)) w = (f32x4){0.f, 0.f, 0.f, 0.f};
          u32x2 o; o.x = pk2(w[0], w[1]); o.y = pk2(w[2], w[3]); *(LAS u32x2*)(WM + t * 136 + s4) = o; } }
    __syncthreads();
    f32x4 acc[8];
#pragma unroll
    for (int n = 0; n < 8; ++n) acc[n] = (f32x4){0.f, 0.f, 0.f, 0.f};
#pragma unroll
    for (int kk = 0; kk < 4; ++kk) { const bf16x8 mf = ldfrag(WM, 136, 16 * wave, 32 * kk, lane);
#pragma unroll
        for (int n = 0; n < 8; ++n) { const bf16x8 nf = ldfragT(VV, 130, 16 * n, 32 * kk, lane); acc[n] = MMA16(nf, mf, acc[n]); } }
    const int t = 16 * wave + (lane & 15), d0 = 4 * (lane >> 4); const float bias = a.in[I_BS][g * 128 + t];
    const bf16* up = Z + (size_t)(tok0 + t) * NZ + 2048 + g * 128 + d0; bf16* yp = Y + (size_t)(tok0 + t) * DM + 512 + g * 128 + d0;
#pragma unroll
    for (int n = 0; n < 8; ++n) { const u32x2 uq = *(const u32x2*)(up + 16 * n);
        u32x2 o; o.x = pk2(bflo(uq.x) * (acc[n][0] + bias), bfhi(uq.x) * (acc[n][1] + bias)); o.y = pk2(bflo(uq.y) * (acc[n][2] + bias), bfhi(uq.y) * (acc[n][3] + bias));
        *(u32x2*)(yp + 16 * n) = o; }
    __syncthreads();
}

__device__ __forceinline__ void p3_scan(const Args& a, int tid, int bid, int G) {
    unsigned char* ws = a.ws; const float* bL = (const float*)(ws + WS_BL); const float* am = (const float*)(ws + WS_AM);
    const unsigned* DC = (const unsigned*)(ws + WS_DC); unsigned* CP = (unsigned*)(ws + WS_CP);
    for (int e2 = bid * NTHREADS + tid; e2 < NBH * DH * DH / 2; e2 += G * NTHREADS) {
        const int bh = e2 >> 13, el = e2 & 8191; float c0 = 0.f, c1 = 0.f, m = 0.f;
#pragma unroll 4
        for (int c = 0; c < NCH; ++c) { const size_t o = ((size_t)(bh * NCH + c) << 13) + el;
            CP[o] = pk2(c0, c1); const unsigned d = DC[o];
            const float M = fmaxf(m, am[bh * 64 + c]), dec = __expf(m - M); m = bL[bh * 64 + c] + M;
            c0 = dec * c0 + bflo(d); c1 = dec * c1 + bfhi(d); }
    }
    const float* DN = (const float*)(ws + WS_DN); float* NP = (float*)(ws + WS_NP);
    for (int e = bid * NTHREADS + tid; e < NBH * DH; e += G * NTHREADS) { const int bh = e >> 7, k = e & 127; float n = 0.f, m = 0.f;
        for (int c = 0; c < NCH; ++c) { const size_t o = (size_t)(bh * NCH + c) * DH + k; NP[o] = n;
            const float M = fmaxf(m, am[bh * 64 + c]), dec = __expf(m - M); m = bL[bh * 64 + c] + M; n = dec * n + DN[o]; } }
}

__device__ __forceinline__ void p4_out_task(const Args& a, LAS unsigned char* lds, int tid, int lane, int wave, int task) {
    unsigned char* ws = a.ws; const bf16* Z = (const bf16*)(ws + WS_Z); bf16* Y = (bf16*)(ws + WS_Y);
    const int bh = task >> 6, c = task & 63, b = bh >> 2, h = bh & 3, tok0 = b * SEQ + c * 64;
    LAS bf16* QS = (LAS bf16*)lds; LAS bf16* KS = (LAS bf16*)(lds + 17408); LAS bf16* VS = (LAS bf16*)(lds + 34816); LAS bf16* CS = (LAS bf16*)(lds + 53504);
    LAS bf16* PS = (LAS bf16*)(lds + 92672); LAS float* NUM = (LAS float*)(lds + 101888); LAS float* AS = (LAS float*)(lds + 139008); LAS float* MT = AS + 64; LAS float* BT = AS + 128;
    const float mp = m_prev_of((const float*)(ws + WS_BL), (const float*)(ws + WS_AM), bh, c);
    const int cc = tid & 15, rp = tid >> 4, r0 = 2 * rp;
    { float o[2][8]; conv2(Z, a.in[I_CW], a.in[I_CB], tok0, c * 64, r0, h * DH + 8 * cc, o);
#pragma unroll
      for (int r = 0; r < 2; ++r) { u32x4 w; w.x = pk2(o[r][0], o[r][1]); w.y = pk2(o[r][2], o[r][3]); w.z = pk2(o[r][4], o[r][5]); w.w = pk2(o[r][6], o[r][7]); *(LAS u32x4*)(QS + (r0 + r) * 136 + 8 * cc) = w; } }
    { float o[2][8]; conv2(Z, a.in[I_CW], a.in[I_CB], tok0, c * 64, r0, 512 + h * DH + 8 * cc, o); const float sc = 0.08838834764831845f;
#pragma unroll
      for (int r = 0; r < 2; ++r) { u32x4 w; w.x = pk2(o[r][0] * sc, o[r][1] * sc); w.y = pk2(o[r][2] * sc, o[r][3] * sc); w.z = pk2(o[r][4] * sc, o[r][5] * sc); w.w = pk2(o[r][6] * sc, o[r][7] * sc); *(LAS u32x4*)(KS + (r0 + r) * 136 + 8 * cc) = w; } }
#pragma unroll
    for (int r = 0; r < 2; ++r) { const u32x4 q = *(const u32x4*)(Z + (size_t)(tok0 + r0 + r) * NZ + 1024 + h * DH + 8 * cc);
        LAS unsigned* d = (LAS unsigned*)(VS + (r0 + r) * 146 + 8 * cc); d[0] = q.x; d[1] = q.y; d[2] = q.z; d[3] = q.w; }
    if (tid < 64) { LAS unsigned* d = (LAS unsigned*)(VS + tid * 146 + 128); d[0] = 0x00003F80u;
#pragma unroll
        for (int e = 1; e < 8; ++e) d[e] = 0u; }
    { const u32x4* src = (const u32x4*)((const bf16*)(ws + WS_CP) + (size_t)task * DH * DH);
#pragma unroll
      for (int i = 0; i < 4; ++i) { const int idx = tid + NTHREADS * i, v = idx >> 4, kc = idx & 15; *(LAS u32x4*)(CS + v * 136 + 8 * kc) = src[idx]; } }
    if (tid < DH) CS[128 * 136 + tid] = (bf16)(pk2(((const float*)(ws + WS_NP))[(size_t)task * DH + tid], 0.f) & 0xffffu);
    for (int i = tid; i < 15 * 68; i += NTHREADS) ((LAS unsigned*)(CS + 129 * 136))[i] = 0u;
    if (tid < 64) { const size_t o = (size_t)bh * SEQ + c * 64 + tid; const float av = ((const float*)(ws + WS_AV))[o]; float pm = av;
#pragma unroll
        for (int d = 1; d < 64; d <<= 1) { const float t = __shfl_up(pm, d); if (lane >= d) pm = fmaxf(pm, t); }
        AS[tid] = av; MT[tid] = fmaxf(mp, pm); BT[tid] = ((const float*)(ws + WS_BC))[o]; }
    __syncthreads();
    const int fr = lane & 15, fq = lane >> 4, mt = wave & 3, hf = wave >> 2, t = 16 * mt + fr;
    {
        const float Mt = MT[t];
#pragma unroll
        for (int nn = 0; nn < 2; ++nn) { const int nt = 2 * hf + nn; f32x4 acc = (f32x4){0.f, 0.f, 0.f, 0.f};
#pragma unroll
            for (int kk = 0; kk < 4; ++kk) acc = MMA16(ldfrag(KS, 136, 16 * nt, 32 * kk, lane), ldfrag(QS, 136, 16 * mt, 32 * kk, lane), acc);
            float p[4];
#pragma unroll
            for (int i = 0; i < 4; ++i) { const int s = 16 * nt + 4 * fq + i; p[i] = (s <= t) ? acc[i] * __expf(AS[s] - Mt) : 0.f; }
            u32x2 o; o.x = pk2(p[0], p[1]); o.y = pk2(p[2], p[3]); *(LAS u32x2*)(PS + t * 72 + 16 * nt + 4 * fq) = o; }
    }
    __syncthreads();
    {
        const int n0 = hf ? 5 : 0, cnt = hf ? 4 : 5;
        f32x4 a1[5], a2[5];
#pragma unroll
        for (int nn = 0; nn < 5; ++nn) { a1[nn] = (f32x4){0.f, 0.f, 0.f, 0.f}; a2[nn] = (f32x4){0.f, 0.f, 0.f, 0.f}; }
#pragma unroll
        for (int kk = 0; kk < 2; ++kk) { const bf16x8 mf = ldfrag(PS, 72, 16 * mt, 32 * kk, lane);
#pragma unroll
            for (int nn = 0; nn < 5; ++nn) if (nn < cnt) a1[nn] = MMA16(ldfragT(VS, 146, 16 * (n0 + nn), 32 * kk, lane), mf, a1[nn]); }
#pragma unroll
        for (int kk = 0; kk < 4; ++kk) { const bf16x8 mf = ldfrag(QS, 136, 16 * mt, 32 * kk, lane);
#pragma unroll
            for (int nn = 0; nn < 5; ++nn) if (nn < cnt) a2[nn] = MMA16(ldfrag(CS, 136, 16 * (n0 + nn), 32 * kk, lane), mf, a2[nn]); }
        const float sc = __expf(mp - MT[t]);
#pragma unroll
        for (int nn = 0; nn < 5; ++nn) if (nn < cnt) {
#pragma unroll
            for (int i = 0; i < 4; ++i) NUM[t * 145 + 16 * (n0 + nn) + 4 * fq + i] = a1[nn][i] + sc * a2[nn][i]; }
    }
    __syncthreads();
    {   const float* ng = a.in[I_MNG] + h * DH;
#pragma unroll 2
        for (int rr = 0; rr < 8; ++rr) { const int tt = 8 * wave + rr; const float den = NUM[tt * 145 + 128];
            const float inv = 1.f / fmaxf(fabsf(den), __expf(-(BT[tt] + MT[tt])));
            const float h0 = NUM[tt * 145 + lane] * inv, h1 = NUM[tt * 145 + 64 + lane] * inv;
            const float r = rsqrtf(wave_sum(h0 * h0 + h1 * h1) * (1.f / DH) + EPS);
            const size_t tok = (size_t)(tok0 + tt); const bf16* op = Z + tok * NZ + 1536 + h * DH;
            const float y0 = h0 * r * ng[lane] * sigmoidf_(bf2f(op[lane])), y1 = h1 * r * ng[64 + lane] * sigmoidf_(bf2f(op[64 + lane]));
            bf16* yp = Y + tok * DM + h * DH; yp[lane] = (bf16)(pk2(y0, 0.f) & 0xffffu); yp[64 + lane] = (bf16)(pk2(y1, 0.f) & 0xffffu); }
    }
    __syncthreads();
}

__device__ __forceinline__ void p5_tables(const Args& a, int tid, int bid, int G) {
    const f32x4* su = (const f32x4*)a.in[I_PU]; const f32x4* sv = (const f32x4*)a.in[I_PV]; u32x4* du = (u32x4*)(a.ws + WS_UB); u32x4* dv = (u32x4*)(a.ws + WS_VB);
    for (int i = bid * NTHREADS + tid; i < NEXP * DM / 8; i += G * NTHREADS) {
        const f32x4 u0 = su[2 * i], u1 = su[2 * i + 1], v0 = sv[2 * i], v1 = sv[2 * i + 1];
        u32x4 o; o.x = pk2(u0[0], u0[1]); o.y = pk2(u0[2], u0[3]); o.z = pk2(u1[0], u1[1]); o.w = pk2(u1[2], u1[3]); du[i] = o;
        o.x = pk2(v0[0], v0[1]); o.y = pk2(v0[2], v0[3]); o.z = pk2(v1[0], v1[1]); o.w = pk2(v1[2], v1[3]); dv[i] = o; }
}

__device__ __forceinline__ void pair_of(int l, int& pa, int& pb) {
    const int a = (l >= 16) + (l >= 24) + (l >= 29) + (l >= 33) + (l >= 36) + (l >= 38) + (l >= 40) + (l >= 42) + (l >= 43) + (l >= 44) + (l >= 45) + (l >= 46) + (l >= 47) + (l >= 48) + (l >= 49);
    const int base = a == 0 ? 0 : a == 1 ? 16 : a == 2 ? 24 : a == 3 ? 29 : a == 4 ? 33 : a == 5 ? 36 : a == 6 ? 38 : a == 7 ? 40 : (34 + a);
    pa = a; pb = l - base;
}
__device__ __forceinline__ void p7_task(const Args& a, LAS unsigned char* lds, int tid, int lane, int wave, int task) {
    unsigned char* ws = a.ws; const bf16* Q = (const bf16*)(ws + WS_Q); const bf16* SKB = (const bf16*)(ws + WS_SKB);
    const int h = task & 7, tt = task >> 3, tokb = tt * 32;
    LAS bf16* QS = (LAS bf16*)lds; LAS bf16* SK = (LAS bf16*)(lds + 16896); LAS float* SC = (LAS float*)(lds + 51712); LAS float* LS = (LAS float*)(lds + 84736); LAS int* LI = (LAS int*)(lds + 88832);
#pragma unroll
    for (int i = 0; i < 2; ++i) { const int idx = tid + NTHREADS * i, r = idx >> 5, cc = idx & 31; *(LAS u32x4*)(QS + r * 264 + 8 * cc) = *(const u32x4*)(Q + (size_t)(tokb + r) * 2048 + h * PQD + 8 * cc); }
    const int fr = lane & 15, fq = lane >> 4, mt = wave & 1, nt0 = 2 * (wave >> 1);
#pragma unroll 1
    for (int p = 0; p < 2; ++p) {
        const u32x4* src = (const u32x4*)(SKB + (size_t)(h * 2 + p) * PKEYS * 128);
#pragma unroll
        for (int i = 0; i < 4; ++i) { const int idx = tid + NTHREADS * i, r = idx >> 4, cc = idx & 15; *(LAS u32x4*)(SK + r * 136 + 8 * cc) = src[idx]; }
        __syncthreads();
#pragma unroll
        for (int nn = 0; nn < 2; ++nn) { const int nt = nt0 + nn; f32x4 acc = (f32x4){0.f, 0.f, 0.f, 0.f};
#pragma unroll
            for (int kk = 0; kk < 4; ++kk) acc = MMA16(ldfrag(SK, 136, 16 * nt, 32 * kk, lane), ldfrag(QS, 264, 16 * mt, p * 128 + 32 * kk, lane), acc);
#pragma unroll
            for (int i = 0; i < 4; ++i) SC[(p * 32 + 16 * mt + fr) * 129 + 16 * nt + 4 * fq + i] = acc[i]; }
        __syncthreads();
    }
#pragma unroll 1
    for (int j = 0; j < 8; ++j) { const int rr = wave * 8 + j, p = rr >> 5, t = rr & 31;
        float v0 = SC[rr * 129 + lane], v1 = SC[rr * 129 + 64 + lane]; float ks = 0.f; int ki = 0;
#pragma unroll 1
        for (int it = 0; it < TOPK; ++it) { const float wm = wave_max(fmaxf(v0, v1));
            const unsigned long long b0 = __ballot(v0 == wm); int key;
            if (b0) { const int src = __ffsll((long long)b0) - 1; key = src; if (lane == src) v0 = -INFINITY; }
            else { const unsigned long long b1 = __ballot(v1 == wm); const int src = __ffsll((long long)b1) - 1; key = 64 + src; if (lane == src) v1 = -INFINITY; }
            if (lane == it) { ks = wm; ki = key; } }
        if (lane < TOPK) { LS[(t * 2 + p) * 16 + lane] = ks; LI[(t * 2 + p) * 16 + lane] = ki; } }
    __syncthreads();
    int pa, pb; pair_of(lane < 50 ? lane : 0, pa, pb);
#pragma unroll 1
    for (int j = 0; j < 4; ++j) { const int t = wave * 4 + j;
        float cand = lane < 50 ? LS[(t * 2) * 16 + pa] + LS[(t * 2 + 1) * 16 + pb] : -INFINITY; float ts = 0.f; int sel = 0;
#pragma unroll 1
        for (int it = 0; it < TOPK; ++it) { const float wm = wave_max(cand); const unsigned long long bb = __ballot(cand == wm); const int src = __ffsll((long long)bb) - 1;
            if (lane == src) cand = -INFINITY; if (lane == it) { ts = wm; sel = src; } }
        const float mx = __shfl(ts, 0); const float e = lane < TOPK ? __expf(ts - mx) : 0.f; const float sum = wave_sum(e);
        if (lane < TOPK) { int sa, sb; pair_of(sel, sa, sb); const int eid = LI[(t * 2) * 16 + sa] * PKEYS + LI[(t * 2 + 1) * 16 + sb];
            const size_t o = (size_t)(tokb + t) * 128 + h * 16 + lane; ((int*)(ws + WS_IDX))[o] = eid; ((float*)(ws + WS_GATE))[o] = e / sum; } }
    __syncthreads();
}

__device__ __forceinline__ void p8_peer(const Args& a, int lane, int gw, int NGW) {
    unsigned char* ws = a.ws; const float* X1 = a.out; const float* sumsq = (const float*)(ws + WS_SSP);
    const bf16* UB = (const bf16*)(ws + WS_UB); const bf16* VB = (const bf16*)(ws + WS_VB); const int* IDX = (const int*)(ws + WS_IDX); const float* GATE = (const float*)(ws + WS_GATE);
    const f32x4* g2 = (const f32x4*)a.in[I_G2] + lane; const f32x4* gf = (const f32x4*)a.in[I_GF] + lane;
    for (int tok = gw; tok < T; tok += NGW) {
        const f32x4* xr = (const f32x4*)(X1 + (size_t)tok * DM) + lane; f32x4 x1[4], xn[4], acc[4];
        const float rs2 = row_rs2(sumsq, tok);
#pragma unroll
        for (int j = 0; j < 4; ++j) { x1[j] = xr[64 * j]; xn[j] = x1[j] * rs2 * g2[64 * j]; acc[j] = (f32x4){0.f, 0.f, 0.f, 0.f}; }
#pragma unroll 2
        for (int hk = 0; hk < 128; ++hk) { const int e = IDX[(size_t)tok * 128 + hk]; const float gt = GATE[(size_t)tok * 128 + hk];
            const u32x2* up = (const u32x2*)(UB + (size_t)e * DM) + lane; const u32x2* vp = (const u32x2*)(VB + (size_t)e * DM) + lane; float d = 0.f; u32x2 vv[4];
#pragma unroll
            for (int j = 0; j < 4; ++j) { const u32x2 q = up[64 * j]; vv[j] = vp[64 * j]; d += (xn[j][0] * bflo(q.x) + xn[j][1] * bfhi(q.x)) + (xn[j][2] * bflo(q.y) + xn[j][3] * bfhi(q.y)); }
            const float av = gelu_tanh(wave_sum(d)) * gt;
#pragma unroll
            for (int j = 0; j < 4; ++j) { acc[j][0] += av * bflo(vv[j].x); acc[j][1] += av * bfhi(vv[j].x); acc[j][2] += av * bflo(vv[j].y); acc[j][3] += av * bfhi(vv[j].y); } }
        float ss = 0.f;
#pragma unroll
        for (int j = 0; j < 4; ++j) { x1[j] += acc[j]; ss += (x1[j][0] * x1[j][0] + x1[j][1] * x1[j][1]) + (x1[j][2] * x1[j][2] + x1[j][3] * x1[j][3]); }
        const float r = rsqrtf(wave_sum(ss) * (1.f / DM) + EPS);
        f32x4* orow = (f32x4*)(a.out + (size_t)tok * DM) + lane;
#pragma unroll
        for (int j = 0; j < 4; ++j) orow[64 * j] = x1[j] * r * gf[64 * j];
    }
}

__global__ void __launch_bounds__(NTHREADS, 2) mk_fwd(Args a) {
    extern __shared__ __attribute__((aligned(16))) unsigned char lds_raw[];
    LAS unsigned char* lds = (LAS unsigned char*)lds_raw;
    const int tid = threadIdx.x, lane = tid & 63, wave = __builtin_amdgcn_readfirstlane(tid >> 6), bid = blockIdx.x, G = gridDim.x;
    unsigned char* ws = a.ws; unsigned* ctl = (unsigned*)(ws + WS_CTL);
    volatile LAS unsigned* MISC = (volatile LAS unsigned*)(lds + LDSCTL_OFF);
    for (int u = tid; u < 64; u += NTHREADS) MISC[u] = 0u;
    __syncthreads();
    XcdBarrier bar; bar.bar = ctl + CW_BAR; bar.x = 0; bar.st = nullptr;
    if (N_LAUNCHES == 1) bar = xcd_barrier_post(ctl + CW_BAR, MISC + 8);
    const int lo = a.ph_lo, hi = a.ph_hi;
#define IN(k) (lo <= (k) && (k) < hi)
#define SEAM(k) do { if (IN(k) && IN((k) + 1)) xcd_barrier(bar); } while (0)
    const int gw = bid * NWAVES + wave, NGW = G * NWAVES;

    if (IN(0)) { p0_prologue(a, lds, tid, lane, wave, bid, G); SEAM(0); }
    if (IN(1)) {
        p1_stats(a, lane, gw);
        pg8::Gemm g{(const bf16*)(ws + WS_XB), (const bf16*)(ws + WS_W1T), T, NZ, DM}; pg8::StaticOrder S; S.init(T, NZ, G, bid);
        EpiZ E{(bf16*)(ws + WS_Z), NZ, (const float*)(ws + WS_RS1), 8};
        pg8::gemm_phase<EpiZ, pg8::StaticOrder, true, true>(lds, g, S, E);
        SEAM(1);
    }
    if (IN(2)) {
        for (int task = bid; task < NBH * NCH + 512; task += G) {
            if (task < NBH * NCH) p2_dc_task(a, lds, tid, lane, wave, task); else p2_gmlp_task(a, lds, tid, lane, wave, task - NBH * NCH); }
        SEAM(2);
    }
    if (IN(3)) { p3_scan(a, tid, bid, G); SEAM(3); }
    if (IN(4)) { for (int task = bid; task < NBH * NCH; task += G) p4_out_task(a, lds, tid, lane, wave, task); SEAM(4); }
    if (IN(5)) {
        pg8::Gemm g{(const bf16*)(ws + WS_Y), (const bf16*)(ws + WS_WOT), T, DM, DM}; pg8::StaticOrder S; S.init(T, DM, G, bid);
        EpiX1 E{a.in[I_X], a.out, (bf16*)(ws + WS_XB1), (float*)(ws + WS_SSP)};
        pg8::gemm_phase<EpiX1, pg8::StaticOrder, true, true>(lds, g, S, E);
        p5_tables(a, tid, bid, G);
        SEAM(5);
    }
    if (IN(6)) {
        pg8::Gemm g{(const bf16*)(ws + WS_XB1), (const bf16*)(ws + WS_WQT), T, 2048, DM}; pg8::StaticOrder S; S.init(T, 2048, G, bid);
        EpiQ E{(bf16*)(ws + WS_Q), 2048, (const float*)(ws + WS_SSP)};
        pg8::gemm_phase<EpiQ, pg8::StaticOrder, true, true>(lds, g, S, E);
        SEAM(6);
    }
    if (IN(7)) { for (int task = bid; task < (T / 32) * PH; task += G) p7_task(a, lds, tid, lane, wave, task); SEAM(7); }
    if (IN(8)) { p8_peer(a, lane, gw, NGW); }
#undef IN
#undef SEAM
}

__global__ void dbg_dump(Args a, int k) {
    unsigned char* ws = a.ws;
    for (size_t i = (size_t)blockIdx.x * 256 + threadIdx.x; i < (size_t)T * DM; i += (size_t)gridDim.x * 256) {
        const size_t t = i >> 10, c = i & 1023; float v = 0.f;
        if (k == 0) { const bf16* XB = (const bf16*)(ws + WS_XB); v = bf2f(XB[i]) + ((const float*)(ws + WS_RS1))[t] + ((const float*)(ws + WS_LF))[i & 65535] + ((const float*)(ws + WS_IG))[i & 65535] + bf2f(((const bf16*)(ws + WS_W1T))[i % (3072 * 1024)]) + bf2f(((const bf16*)(ws + WS_WQT))[i % (2048 * 1024)]) + bf2f(((const bf16*)(ws + WS_WOT))[i % (1024 * 1024)]); }
        if (k == 1) { const bf16* Z = (const bf16*)(ws + WS_Z) + t * NZ; v = bf2f(Z[c]) + bf2f(Z[1024 + c]) + bf2f(Z[2048 + c]) + ((const float*)(ws + WS_BC))[i & 65535] + ((const float*)(ws + WS_AV))[i & 65535]; }
        if (k == 2) {
#if !defined(DBG_SUB) || DBG_SUB == 0
            v = bf2f(((const bf16*)(ws + WS_DC))[i]);
#elif DBG_SUB == 1
            v = bf2f(((const bf16*)(ws + WS_Y))[t * DM + 512 + (c & 511)]);
#else
            v = ((const float*)(ws + WS_DN))[i & 131071];
#endif
        }
        if (k == 3) { v = bf2f(((const bf16*)(ws + WS_CP))[i]) + ((const float*)(ws + WS_NP))[i & 131071]; }
        if (k == 4) { v = bf2f(((const bf16*)(ws + WS_Y))[i]); }
        if (k == 6) { const bf16* Q = (const bf16*)(ws + WS_Q) + t * 2048; v = bf2f(Q[c]) + bf2f(Q[1024 + c]); }
        if (k == 7) { v = c < 128 ? (float)((const int*)(ws + WS_IDX))[t * 128 + c] : c < 256 ? ((const float*)(ws + WS_GATE))[t * 128 + c - 128] : 0.f; }
        a.out[i] = v;
    }
}
extern "C" void kernel_launch(void* const* d_in, const int* in_sizes, int n_in, void* d_out, int out_size, void* d_ws, size_t ws_size, hipStream_t stream) {
    static int grid = 0;
    if (grid == 0) {
        if (n_in != 19 || in_sizes[0] != T * DM || out_size != T * DM || ws_size < WS_END) { fprintf(stderr, "kernel_launch: unexpected shapes (n_in %d, in0 %d, out %d, ws %zu); nothing launched\n", n_in, n_in > 0 ? in_sizes[0] : -1, out_size, ws_size); grid = -1; return; }
        int dev = 0, cus = 0;
        if (hipGetDevice(&dev) != hipSuccess || hipDeviceGetAttribute(&cus, hipDeviceAttributeMultiprocessorCount, dev) != hipSuccess) { grid = -1; return; }
        if (hipFuncSetAttribute((const void*)mk_fwd, hipFuncAttributeMaxDynamicSharedMemorySize, LDS_BYTES) != hipSuccess) { fprintf(stderr, "kernel_launch: hipFuncSetAttribute failed\n"); grid = -1; return; }
        (void)hipGetLastError();
        grid = cus;
    }
    if (grid < 0) return;
    (void)hipMemsetAsync((char*)d_ws + WS_CTL, 0, CTL_ZERO_BYTES, stream);
    Args a{};
    for (int i = 0; i < 19; ++i) a.in[i] = (const float*)d_in[i];
    a.out = (float*)d_out; a.ws = (unsigned char*)d_ws;
    if (N_LAUNCHES == 1) { a.ph_lo = 0; a.ph_hi = NPHASE; hipLaunchKernelGGL(mk_fwd, dim3(grid), dim3(NTHREADS), LDS_BYTES, stream, a); }
    else {
#ifndef DBG_STOP
#define DBG_STOP (NPHASE - 1)
#endif
        for (int p = 0; p <= DBG_STOP; ++p) { a.ph_lo = p; a.ph_hi = p + 1; hipLaunchKernelGGL(mk_fwd, dim3(grid), dim3(NTHREADS), LDS_BYTES, stream, a); }
        if (DBG_STOP < NPHASE - 1 && DBG_STOP != 5) hipLaunchKernelGGL(dbg_dump, dim3(2048), dim3(256), 0, stream, a, (int)DBG_STOP);
    }
}
```

```cpp
#include <hip/hip_runtime.h>
#include <cstdio>
#include <cstdint>

#ifndef MK_N_LAUNCHES
#define MK_N_LAUNCHES 1
#endif

#define LAS __attribute__((address_space(3)))
#define GAS __attribute__((address_space(1)))
typedef unsigned short bf16;
typedef short bf16x8 __attribute__((ext_vector_type(8)));
typedef float f32x4 __attribute__((ext_vector_type(4)));
typedef float f32x2 __attribute__((ext_vector_type(2)));
typedef _Float16 f16x2 __attribute__((ext_vector_type(2)));
typedef unsigned u32x4 __attribute__((ext_vector_type(4)));
typedef unsigned u32x2 __attribute__((ext_vector_type(2)));

namespace pg8 {
typedef unsigned short bf16_t;
constexpr int BM = 256, BK = 64, HALF = 128, HTB = HALF * BK * 2, STAGE_BYTES = 8 * HTB, NXCD = 8, WGM = 8;
__host__ __device__ __forceinline__ int lds_byte(int r, int c) { const int st = (r >> 4) * 2 + (c >> 5), rr = r & 15, cc = c & 31, ob = rr * 64 + cc * 2; return st * 1024 + (ob ^ (((ob >> 9) & 1) << 5)); }
__host__ __device__ __forceinline__ void stage_rc(int b, int& R, int& C) { const int st = b / 1024, sb = b % 1024, swz = sb ^ (((sb >> 9) & 1) << 5); R = (st >> 1) * 16 + swz / 64; C = (st & 1) * 32 + (swz % 64) / 2; }
__host__ __device__ __forceinline__ int perm32(int rho) { const int n = rho >> 4, i = rho & 15; return 8 * (i >> 2) + 4 * n + (i & 3); }
struct Unit { int pm, pn; };
struct Gemm { const bf16_t* A; const bf16_t* Bt; int M, N, K; };
struct StaticOrder {
    int nM, nN, nwg, G, c;
    __host__ __device__ void init(int M, int N, int G_, int c_) { nM = M / BM; nN = N / BM; nwg = nM * nN; G = G_; c = c_; }
    __host__ __device__ bool next(int i, Unit& u) const {
        const long L = (long)i * G + c; if (L >= nwg) return false;
        int wgid = (int)L; { const int q = nwg / NXCD, r = nwg % NXCD, xcd = wgid % NXCD, off = wgid / NXCD; wgid = (xcd < r ? xcd * (q + 1) : r * (q + 1) + (xcd - r) * q) + off; }
        const int nig = WGM * nN, gid = wgid / nig, fm = gid * WGM, gsz = (nM - fm) < WGM ? (nM - fm) : WGM;
        u.pm = fm + ((wgid % nig) % gsz); u.pn = (wgid % nig) / gsz; return true;
    }
    __device__ __forceinline__ void a_ready(const Unit&) const {}
    __device__ __forceinline__ void done(const Unit&) const {}
};
typedef __bf16 bf16x2_t __attribute__((ext_vector_type(2)));
__device__ __forceinline__ unsigned cvt_pk_bf16(float lo, float hi) { const f32x2 v = {lo, hi}; const bf16x2_t b = __builtin_convertvector(v, bf16x2_t); return __builtin_bit_cast(unsigned, b); }

template <class Epi, class Sched, bool ALIGN_EPI = false, bool SP2 = false>
__device__ __forceinline__ void gemm_phase(LAS unsigned char* lds, const Gemm g, const Sched& S, const Epi& E) {
    const int tid = threadIdx.x, wid = __builtin_amdgcn_readfirstlane(tid >> 6), lane = tid & 63, wr = wid >> 2, wc = wid & 3, fr = lane & 15, fq = lane >> 4;
    const int K = g.K, nt = K / BK;
    unsigned voffA[2], voffB[2];
#pragma unroll
    for (int i = 0; i < 2; ++i) { int R, C; stage_rc(tid * 16 + i * 8192, R, C); const int Rb = Epi::PERM ? ((R & ~31) + perm32(R & 31)) : R;
        voffA[i] = (unsigned)(R * K + C) * 2u; voffB[i] = (unsigned)(Rb * K + C) * 2u; }
    const size_t kstep = (size_t)(BK * 2);
    const size_t hstep = (size_t)HALF * K * 2;
    const size_t tstep = 2 * hstep;
    const unsigned ldsw = (unsigned)wid * 1024u;
    const int aoff = lds_byte(wr * 64 + fr, fq * 8), boff = lds_byte(wc * 32 + fr, fq * 8);
#define PG8_SA(b, h) (((b) * 2 + (h)) * HTB)
#define PG8_SB(b, h) ((4 + (b) * 2 + (h)) * HTB)
#define PG8_STAGE(bufoff, gbase, voff) do { _Pragma("unroll") for (int _i = 0; _i < 2; ++_i) \
        __builtin_amdgcn_global_load_lds((const unsigned*)((const char*)(gbase) + (voff)[_i]), (LAS unsigned*)(lds + (bufoff) + ldsw + _i * 8192), 16, 0, 0); } while (0)
#define PG8_LDA(dst, b, h) do { _Pragma("unroll") for (int m = 0; m < 4; ++m) _Pragma("unroll") for (int k = 0; k < 2; ++k) dst[m][k] = *(const LAS bf16x8*)(lds + PG8_SA(b, h) + aoff + m * 2048 + k * 1024); } while (0)
#define PG8_LDB(dst, b, h) do { _Pragma("unroll") for (int n = 0; n < 2; ++n) _Pragma("unroll") for (int k = 0; k < 2; ++k) dst[n][k] = *(const LAS bf16x8*)(lds + PG8_SB(b, h) + boff + n * 2048 + k * 1024); } while (0)
#define PG8_MMA(ai, bj, At, Bt) do { __builtin_amdgcn_s_setprio(1); _Pragma("unroll") for (int m = 0; m < 4; ++m) _Pragma("unroll") for (int n = 0; n < 2; ++n) _Pragma("unroll") for (int k = 0; k < 2; ++k) \
        acc[ai][bj][m][n] = __builtin_amdgcn_mfma_f32_16x16x32_bf16(Bt[n][k], At[m][k], acc[ai][bj][m][n], 0, 0, 0); __builtin_amdgcn_s_setprio(0); } while (0)
#define PG8_WAIT_V(n) asm volatile("s_waitcnt vmcnt(" #n ")" ::: "memory")
#define PG8_WAIT_L(n) asm volatile("s_waitcnt lgkmcnt(" #n ")" ::: "memory")
#define PG8_BAR __builtin_amdgcn_s_barrier()
#define PG8_SCHED __builtin_amdgcn_sched_barrier(0)
    Unit cur, nxt; int ui = 0;
    if (!S.next(0, cur)) return;
    f32x4 acc[2][2][4][2];
#pragma unroll
    for (int a = 0; a < 2; ++a)
#pragma unroll
        for (int b = 0; b < 2; ++b)
#pragma unroll
            for (int m = 0; m < 4; ++m)
#pragma unroll
                for (int n = 0; n < 2; ++n) acc[a][b][m][n] = (f32x4){0.f, 0.f, 0.f, 0.f};
    bf16x8 At[4][2], B0[2][2], B1[2][2];
    const char* cA = (const char*)g.A + (size_t)cur.pm * tstep; const char* cB = (const char*)g.Bt + (size_t)cur.pn * tstep;
    S.a_ready(cur);
    if constexpr (SP2) {
        PG8_STAGE(PG8_SB(0, 0), cB, voffB); PG8_STAGE(PG8_SB(0, 1), cB + hstep, voffB); PG8_STAGE(PG8_SA(0, 0), cA, voffA); PG8_STAGE(PG8_SA(0, 1), cA + hstep, voffA);
        if (wr == 1) PG8_BAR;
        PG8_WAIT_V(2); PG8_BAR;
        PG8_STAGE(PG8_SB(1, 0), cB + kstep, voffB); PG8_STAGE(PG8_SA(1, 0), cA + kstep, voffA); PG8_STAGE(PG8_SB(1, 1), cB + hstep + kstep, voffB);
        PG8_WAIT_V(6); PG8_BAR;
    } else {
        PG8_STAGE(PG8_SB(0, 0), cB, voffB); PG8_STAGE(PG8_SA(0, 0), cA, voffA); PG8_STAGE(PG8_SB(0, 1), cB + hstep, voffB); PG8_STAGE(PG8_SA(0, 1), cA + hstep, voffA);
        if (wr == 1) PG8_BAR;
        PG8_WAIT_V(4); PG8_BAR;
        PG8_STAGE(PG8_SB(1, 0), cB + kstep, voffB); PG8_STAGE(PG8_SA(1, 0), cA + kstep, voffA); PG8_STAGE(PG8_SB(1, 1), cB + hstep + kstep, voffB);
        PG8_WAIT_V(6); PG8_BAR;
    }
    for (;;) {
        const bool has_next = S.next(ui + 1, nxt);
        const char* nA = has_next ? (const char*)g.A + (size_t)nxt.pm * tstep : cA; const char* nB = has_next ? (const char*)g.Bt + (size_t)nxt.pn * tstep : cB;
        for (int t = 0; t < nt; t += 2) {
            const bool last = (t == nt - 2);
            const char* a1 = cA + (size_t)(t + 1) * kstep;
            const char* a2 = last ? nA : cA + (size_t)(t + 2) * kstep; const char* b2 = last ? nB : cB + (size_t)(t + 2) * kstep;
            const char* a3 = a2 + kstep; const char* b3 = b2 + kstep;
            if (last && has_next) S.a_ready(nxt);
            if constexpr (SP2) {
            PG8_LDB(B0, 0, 0); PG8_LDB(B1, 0, 1); PG8_SCHED; PG8_LDA(At, 0, 0); PG8_STAGE(PG8_SA(1, 1), a1 + hstep, voffA);
            PG8_WAIT_V(8); PG8_WAIT_L(0); PG8_BAR; PG8_MMA(0, 0, At, B0); PG8_MMA(0, 1, At, B1); PG8_BAR; PG8_SCHED;
            PG8_LDA(At, 0, 1); PG8_STAGE(PG8_SB(0, 0), b2, voffB); PG8_STAGE(PG8_SB(0, 1), b2 + hstep, voffB); PG8_STAGE(PG8_SA(0, 0), a2, voffA);
            PG8_WAIT_V(8); PG8_WAIT_L(0); PG8_BAR; PG8_MMA(1, 0, At, B0); PG8_MMA(1, 1, At, B1); PG8_BAR; PG8_SCHED;
            PG8_LDB(B0, 1, 0); PG8_LDB(B1, 1, 1); PG8_SCHED; PG8_LDA(At, 1, 0); PG8_STAGE(PG8_SA(0, 1), a2 + hstep, voffA);
            PG8_WAIT_V(8); PG8_WAIT_L(0); PG8_BAR; PG8_MMA(0, 0, At, B0); PG8_MMA(0, 1, At, B1); PG8_BAR; PG8_SCHED;
            PG8_LDA(At, 1, 1); PG8_STAGE(PG8_SB(1, 0), b3, voffB); PG8_STAGE(PG8_SB(1, 1), b3 + hstep, voffB); PG8_STAGE(PG8_SA(1, 0), a3, voffA);
            PG8_WAIT_V(8); PG8_WAIT_L(0); PG8_BAR; PG8_MMA(1, 0, At, B0); PG8_MMA(1, 1, At, B1); PG8_BAR; PG8_SCHED;
            } else {
            PG8_LDB(B0, 0, 0); PG8_SCHED; PG8_LDA(At, 0, 0); PG8_STAGE(PG8_SA(1, 1), a1 + hstep, voffA);
            PG8_WAIT_L(8); PG8_BAR; PG8_WAIT_L(0); PG8_MMA(0, 0, At, B0); PG8_BAR; PG8_SCHED;
            PG8_LDB(B1, 0, 1); PG8_STAGE(PG8_SB(0, 0), b2, voffB);
            PG8_BAR; PG8_WAIT_L(0); PG8_MMA(0, 1, At, B1); PG8_BAR;
            PG8_LDA(At, 0, 1); PG8_STAGE(PG8_SA(0, 0), a2, voffA);
            PG8_BAR; PG8_WAIT_L(0); PG8_MMA(1, 0, At, B0); PG8_BAR; PG8_SCHED;
            PG8_STAGE(PG8_SB(0, 1), b2 + hstep, voffB);
            PG8_WAIT_V(6); PG8_BAR; PG8_MMA(1, 1, At, B1); PG8_BAR;
            PG8_LDB(B0, 1, 0); PG8_SCHED; PG8_LDA(At, 1, 0); PG8_STAGE(PG8_SA(0, 1), a2 + hstep, voffA);
            PG8_WAIT_L(8); PG8_BAR; PG8_WAIT_L(0); PG8_MMA(0, 0, At, B0); PG8_BAR; PG8_SCHED;
            PG8_LDB(B1, 1, 1); PG8_STAGE(PG8_SB(1, 0), b3, voffB);
            PG8_BAR; PG8_WAIT_L(0); PG8_MMA(0, 1, At, B1); PG8_BAR;
            PG8_LDA(At, 1, 1); PG8_STAGE(PG8_SA(1, 0), a3, voffA);
            PG8_BAR; PG8_WAIT_L(0); PG8_MMA(1, 0, At, B0); PG8_BAR; PG8_SCHED;
            PG8_STAGE(PG8_SB(1, 1), b3 + hstep, voffB);
            PG8_WAIT_V(6); PG8_BAR; PG8_MMA(1, 1, At, B1); PG8_BAR;
            }
        }
        if constexpr (ALIGN_EPI) { if (wr == 0) PG8_BAR; }
        E(acc, cur, wr, wc, fr, fq);
        if (!has_next) break;
#pragma unroll
        for (int a = 0; a < 2; ++a)
#pragma unroll
            for (int b = 0; b < 2; ++b)
#pragma unroll
                for (int m = 0; m < 4; ++m)
#pragma unroll
                    for (int n = 0; n < 2; ++n) acc[a][b][m][n] = (f32x4){0.f, 0.f, 0.f, 0.f};
        cur = nxt; cA = nA; cB = nB; ++ui;
        if constexpr (ALIGN_EPI) { if (wr == 1) PG8_BAR; }
    }
    PG8_WAIT_V(0);
    if constexpr (!ALIGN_EPI) { if (wr == 0) PG8_BAR; }
    PG8_BAR;
#undef PG8_SA
#undef PG8_SB
#undef PG8_STAGE
#undef PG8_LDA
#undef PG8_LDB
#undef PG8_MMA
#undef PG8_WAIT_V
#undef PG8_WAIT_L
#undef PG8_BAR
#undef PG8_SCHED
}
}

constexpr int NWAVES = 8, NTHREADS = 512;
constexpr int BATCH = 4, SEQ = 4096, DM = 1024, T = BATCH * SEQ;
constexpr int NH = 4, DH = 128, MW = 512, NIN = 3080, NZ = 3072, NBH = BATCH * NH, NCH = SEQ / 64;
constexpr int PH = 8, PKEYS = 128, PQD = 256, TOPK = 16, NEXP = 16384;
constexpr float EPS = 1e-6f;
constexpr int NPHASE = 11;
constexpr int N_LAUNCHES = MK_N_LAUNCHES;

constexpr size_t MiB = 1u << 20;
constexpr size_t WS_CTL = 0, CTL_ZERO_BYTES = 1 * MiB;
constexpr size_t WS_SUMSQ2 = 128 * 1024;
constexpr size_t WS_RS1 = 1 * MiB;
constexpr size_t WS_LF = WS_RS1 + (size_t)T * 4;
constexpr size_t WS_IG = WS_LF + (size_t)NBH * SEQ * 4;
constexpr size_t WS_BC = WS_IG + (size_t)NBH * SEQ * 4;
constexpr size_t WS_AV = WS_BC + (size_t)NBH * SEQ * 4;
constexpr size_t WS_BL = WS_AV + (size_t)NBH * SEQ * 4;
constexpr size_t WS_AM = WS_BL + (size_t)NBH * NCH * 4;
constexpr size_t WS_DN = WS_AM + (size_t)NBH * NCH * 4;
constexpr size_t WS_NP = WS_DN + (size_t)NBH * NCH * DH * 4;
constexpr size_t WS_SU = WS_NP + (size_t)NBH * NCH * DH * 4;
constexpr size_t WS_SV = WS_SU + (size_t)NEXP * 4;
constexpr size_t WS_SMALL_END = WS_SV + (size_t)NEXP * 4;
constexpr size_t WS_W1T = 4 * MiB, WS_WOT = 10 * MiB, WS_WQT = 12 * MiB, WS_SKB = 16 * MiB;
constexpr size_t WS_XB = 17 * MiB, WS_Y = WS_XB;
constexpr size_t WS_XB1 = 49 * MiB;
constexpr size_t WS_Z = 81 * MiB;
constexpr size_t WS_Q = WS_Z, WS_IDX = WS_Z + 64 * MiB, WS_GATE = WS_Z + 72 * MiB;
constexpr size_t WS_DC = 177 * MiB, WS_UB = WS_DC;
constexpr size_t WS_CP = 209 * MiB, WS_VB = WS_CP;
constexpr size_t WS_SSP = 241 * MiB;
constexpr size_t WS_SSP2 = 242 * MiB;
constexpr size_t WS_COEF = WS_Z + 80 * MiB, WS_COEF_OS = WS_COEF + 7 * MiB;
constexpr size_t WS_APART = WS_Q;
constexpr size_t WS_END = 243 * MiB;
static_assert(WS_SMALL_END <= WS_W1T && WS_SKB + 512 * 1024 <= WS_XB, "ws map");
constexpr int CW_TMO = 0, CW_CODE = 1, CW_BAR = 4096;

constexpr int LDS_BYTES = 147456, LDSCTL_OFF = LDS_BYTES - 256;

typedef GAS unsigned gu32;
#define RLX_AGENT __ATOMIC_RELAXED, __HIP_MEMORY_SCOPE_AGENT
#define LDS_WAIT() asm volatile("s_waitcnt lgkmcnt(0)" ::: "memory")
__device__ __forceinline__ unsigned pk2(float lo, float hi) { return pg8::cvt_pk_bf16(lo, hi); }
__device__ __forceinline__ float bf2f(unsigned short b) { return __uint_as_float((unsigned)b << 16); }
__device__ __forceinline__ float bflo(unsigned w) { return __uint_as_float(w << 16); }
__device__ __forceinline__ float bfhi(unsigned w) { return __uint_as_float(w & 0xffff0000u); }
__device__ __forceinline__ float wave_sum(float v) {
#pragma unroll
    for (int o = 1; o < 64; o <<= 1) v += __shfl_xor(v, o);
    return v;
}
__device__ __forceinline__ float wave_max(float v) {
#pragma unroll
    for (int o = 1; o < 64; o <<= 1) v = fmaxf(v, __shfl_xor(v, o));
    return v;
}
__device__ __forceinline__ float sigmoidf_(float x) { return __builtin_amdgcn_rcpf(1.f + __expf(-x)); }
__device__ __forceinline__ float siluf_(float x) { return x * sigmoidf_(x); }
__device__ __forceinline__ float gelu_tanh(float x) { const float u = 1.5957691216057308f * (x + 0.044715f * x * x * x); return x * sigmoidf_(u); }

#define XB_TMO      128
#define XB_XCNT(j)  (256  + 64 * (j))
#define XB_XSUB(j)  (1280 + 64 * (j))
#define XB_XGEN(j)  (2304 + 64 * (j))
#define XB_TOP      3328
#define XB_TOPGEN   3392
#define XCD_BAR_WORDS 3456
#define XB_SPIN_CAP (1u << 18)
__device__ __forceinline__ unsigned xb_ld(unsigned* p)              { return __hip_atomic_load(p, __ATOMIC_RELAXED, __HIP_MEMORY_SCOPE_AGENT); }
__device__ __forceinline__ unsigned xb_add(unsigned* p, unsigned v) { return __hip_atomic_fetch_add(p, v, __ATOMIC_RELAXED, __HIP_MEMORY_SCOPE_AGENT); }
__device__ __forceinline__ unsigned xb_xcc_id() { return (unsigned)__builtin_amdgcn_s_getreg((3 << 11) | 20) & 0xFu; }
#define XB_SPIN(cond, bar) do { unsigned _sp = 0; while (cond) { __builtin_amdgcn_s_sleep(1); \
    if ((++_sp & 255u) == 0u) { if (xb_ld(&(bar)[XB_TMO])) break; if (_sp > XB_SPIN_CAP) { atomicAdd(&(bar)[XB_TMO], 1u); break; } } } } while (0)
struct XcdBarrier { unsigned* bar; unsigned x; volatile LAS unsigned* st; };
__device__ __forceinline__ XcdBarrier xcd_barrier_post(unsigned* bar, volatile LAS unsigned* st) {
    XcdBarrier b; b.bar = bar; b.x = xb_xcc_id(); b.st = st;
    if (threadIdx.x == 0) (void)xb_add(&bar[XB_XCNT(b.x)], 1u);
    return b;
}
__device__ __forceinline__ void xcd_barrier_complete(unsigned* bar, unsigned x, unsigned& nloc, unsigned& nx) {
    const unsigned G = gridDim.x * gridDim.y * gridDim.z;
    unsigned sum, cnt, mine, sp = 0u;
    for (;;) {
        sum = 0u; cnt = 0u; mine = 0u;
#pragma unroll
        for (unsigned j = 0; j < 16; ++j) { const unsigned c = xb_ld(&bar[XB_XCNT(j)]); sum += c; cnt += (c > 0u) ? 1u : 0u; mine = (j == x) ? c : mine; }
        if (sum == G) break;
        __builtin_amdgcn_s_sleep(1);
        if ((++sp & 255u) == 0u) { if (xb_ld(&bar[XB_TMO])) break; if (sp > XB_SPIN_CAP) { atomicAdd(&bar[XB_TMO], 1u); break; } }
    }
    nloc = mine > 0u ? mine : 1u; nx = cnt > 0u ? cnt : 1u;
}
__device__ __forceinline__ void xcd_barrier(const XcdBarrier& b) {
    asm volatile("s_waitcnt vmcnt(0)" ::: "memory");
    __syncthreads();
    if (threadIdx.x == 0) {
        unsigned* bar = b.bar;
        __builtin_amdgcn_s_waitcnt(0);
        unsigned nloc = b.st[0], nx = b.st[1];
        if (nloc == 0u) { xcd_barrier_complete(bar, b.x, nloc, nx); b.st[0] = nloc; b.st[1] = nx; }
        const unsigned old = xb_add(&bar[XB_XSUB(b.x)], 1u);
        const unsigned gen = old / nloc;
        if (old + 1u == (gen + 1u) * nloc) {
            __builtin_amdgcn_fence(__ATOMIC_RELEASE, "agent");
            asm volatile("s_waitcnt vmcnt(0)" ::: "memory");
            const unsigned og = xb_add(&bar[XB_TOP], 1u);
            const unsigned tg = og / nx;
            if (og + 1u == (tg + 1u) * nx) xb_add(&bar[XB_TOPGEN], 1u);
            else XB_SPIN(xb_ld(&bar[XB_TOPGEN]) == tg, bar);
            __builtin_amdgcn_fence(__ATOMIC_ACQUIRE, "agent");
            xb_add(&bar[XB_XGEN(b.x)], 1u);
            asm volatile("s_waitcnt vmcnt(0)" ::: "memory");
        } else {
            XB_SPIN(xb_ld(&bar[XB_XGEN(b.x)]) == gen, bar);
            __builtin_amdgcn_fence(__ATOMIC_ACQUIRE, "agent");
            asm volatile("s_waitcnt vmcnt(0)" ::: "memory");
        }
    }
    __syncthreads();
}

__device__ __forceinline__ bf16x8 ldfrag(const LAS bf16* img, int ld, int i0, int k0, int lane) {
    return *(const LAS bf16x8*)(img + (i0 + (lane & 15)) * ld + k0 + 8 * (lane >> 4));
}
typedef short s16x4 __attribute__((ext_vector_type(4)));
__device__ __forceinline__ bf16x8 ldfragT(const LAS bf16* img, int ld, int i0, int k0, int lane) {
    const LAS bf16* p = img + (k0 + 8 * (lane >> 4) + ((lane & 15) >> 2)) * ld + i0 + 4 * (lane & 3);
    const s16x4 a = __builtin_amdgcn_ds_read_tr16_b64_v4i16((LAS s16x4*)p), b = __builtin_amdgcn_ds_read_tr16_b64_v4i16((LAS s16x4*)(p + 4 * ld));
    return (bf16x8){a[0], a[1], a[2], a[3], b[0], b[1], b[2], b[3]};
}
#define MMA16(nf, mf, acc) __builtin_amdgcn_mfma_f32_16x16x32_bf16(nf, mf, acc, 0, 0, 0)

__device__ __forceinline__ float row_rs2(const float* ssp, int r) {
    const f32x4* p = (const f32x4*)(ssp + (size_t)r * 16); const f32x4 a = p[0], b = p[1], c = p[2], d = p[3];
    const float s = (((a[0] + a[1]) + (a[2] + a[3])) + ((b[0] + b[1]) + (b[2] + b[3]))) + (((c[0] + c[1]) + (c[2] + c[3])) + ((d[0] + d[1]) + (d[2] + d[3])));
    return rsqrtf(s * (1.f / 1024.f) + 1e-6f);
}
template <int S2, int S1, int S0>
__device__ __forceinline__ void bfly16(float (&v)[16], int rank) {
    { const bool b = (rank >> 2) & 1;
#pragma unroll
      for (int j = 0; j < 8; ++j) { const float keep = b ? v[8 + j] : v[j], send = b ? v[j] : v[8 + j]; v[j] = keep + __shfl_xor(send, S2); } }
    { const bool b = (rank >> 1) & 1;
#pragma unroll
      for (int j = 0; j < 4; ++j) { const float keep = b ? v[4 + j] : v[j], send = b ? v[j] : v[4 + j]; v[j] = keep + __shfl_xor(send, S1); } }
    { const bool b = rank & 1;
#pragma unroll
      for (int j = 0; j < 2; ++j) { const float keep = b ? v[2 + j] : v[j], send = b ? v[j] : v[2 + j]; v[j] = keep + __shfl_xor(send, S0); } }
}
template <int S2, int S1, int S0>
__device__ __forceinline__ void bfly16i(int (&v)[16], int rank) {
    { const bool b = (rank >> 2) & 1;
#pragma unroll
      for (int j = 0; j < 8; ++j) { const int keep = b ? v[8 + j] : v[j], send = b ? v[j] : v[8 + j]; v[j] = keep + __shfl_xor(send, S2); } }
    { const bool b = (rank >> 1) & 1;
#pragma unroll
      for (int j = 0; j < 4; ++j) { const int keep = b ? v[4 + j] : v[j], send = b ? v[j] : v[4 + j]; v[j] = keep + __shfl_xor(send, S1); } }
    { const bool b = rank & 1;
#pragma unroll
      for (int j = 0; j < 2; ++j) { const int keep = b ? v[2 + j] : v[j], send = b ? v[j] : v[2 + j]; v[j] = keep + __shfl_xor(send, S0); } }
}
typedef pg8::Unit Unit;
struct EpiZ {
    static constexpr bool PERM = true;
    bf16* O; int ldc; const float* rs; int act_pn;
    __device__ __forceinline__ void operator()(const f32x4 (&acc)[2][2][4][2], const Unit& u, int wr, int wc, int fr, int fq) const {
        const int row0 = u.pm * 256 + wr * 64 + fr, col0 = u.pn * 256 + wc * 32 + 8 * fq; const bool act = u.pn >= act_pn;
#pragma unroll
        for (int ai = 0; ai < 2; ++ai)
#pragma unroll
            for (int m = 0; m < 4; ++m) { const int r = row0 + ai * 128 + m * 16; const float s = rs[r]; bf16* rowp = O + (size_t)r * ldc + col0;
#pragma unroll
                for (int bj = 0; bj < 2; ++bj) { f32x4 v0 = acc[ai][bj][m][0] * s, v1 = acc[ai][bj][m][1] * s;
                    if (act) {
#pragma unroll
                        for (int e = 0; e < 4; ++e) { v0[e] = gelu_tanh(v0[e]); v1[e] = gelu_tanh(v1[e]); } }
                    u32x4 w; w.x = pk2(v0[0], v0[1]); w.y = pk2(v0[2], v0[3]); w.z = pk2(v1[0], v1[1]); w.w = pk2(v1[2], v1[3]);
                    *(u32x4*)(rowp + bj * 128) = w; } }
    }
};
struct EpiQ {
    static constexpr bool PERM = true;
    bf16* O; int ldc; const float* sumsq;
    __device__ __forceinline__ void operator()(const f32x4 (&acc)[2][2][4][2], const Unit& u, int wr, int wc, int fr, int fq) const {
        const int row0 = u.pm * 256 + wr * 64 + fr, col0 = u.pn * 256 + wc * 32 + 8 * fq;
#pragma unroll
        for (int ai = 0; ai < 2; ++ai)
#pragma unroll
            for (int m = 0; m < 4; ++m) { const int r = row0 + ai * 128 + m * 16; const float s = row_rs2(sumsq, r); bf16* rowp = O + (size_t)r * ldc + col0;
#pragma unroll
                for (int bj = 0; bj < 2; ++bj) { const f32x4 v0 = acc[ai][bj][m][0] * s, v1 = acc[ai][bj][m][1] * s;
                    u32x4 w; w.x = pk2(v0[0], v0[1]); w.y = pk2(v0[2], v0[3]); w.z = pk2(v1[0], v1[1]); w.w = pk2(v1[2], v1[3]);
                    *(u32x4*)(rowp + bj * 128) = w; } }
    }
};
struct EpiX1 {
    static constexpr bool PERM = true;
    const float* X; bf16* XB1; float* sumsq;
    __device__ __forceinline__ void operator()(const f32x4 (&acc)[2][2][4][2], const Unit& u, int wr, int wc, int fr, int fq) const {
        const int row0 = u.pm * 256 + wr * 64 + fr, col0 = u.pn * 256 + wc * 32 + 8 * fq;
#pragma unroll
        for (int ai = 0; ai < 2; ++ai)
#pragma unroll
            for (int m = 0; m < 4; ++m) { const int r = row0 + ai * 128 + m * 16; float ss = 0.f;
#pragma unroll
                for (int bj = 0; bj < 2; ++bj) { const size_t off = (size_t)r * DM + col0 + bj * 128;
                    const f32x4 xa = *(const f32x4*)(X + off), xb = *(const f32x4*)(X + off + 4);
                    const f32x4 v0 = acc[ai][bj][m][0] + xa, v1 = acc[ai][bj][m][1] + xb;
                    u32x4 w; w.x = pk2(v0[0], v0[1]); w.y = pk2(v0[2], v0[3]); w.z = pk2(v1[0], v1[1]); w.w = pk2(v1[2], v1[3]);
                    *(u32x4*)(XB1 + off) = w;
                    ss += (v0[0] * v0[0] + v0[1] * v0[1]) + (v0[2] * v0[2] + v0[3] * v0[3]) + (v1[0] * v1[0] + v1[1] * v1[1]) + (v1[2] * v1[2] + v1[3] * v1[3]); }
                ss += __shfl_xor(ss, 16); ss += __shfl_xor(ss, 32);
                if (fq == 0) sumsq[(size_t)r * 16 + u.pn * 4 + wc] = ss; }
    }
};

struct Args { const float* in[19]; float* out; unsigned char* ws; int ph_lo, ph_hi; };
enum { I_X = 0, I_G1, I_WIN, I_CW, I_CB, I_BI, I_BF, I_MNG, I_LNG, I_LNB, I_WS, I_BS, I_WOUT, I_G2, I_WQ, I_SK, I_PU, I_PV, I_GF };

__device__ __forceinline__ void transpose_item(const float* W, int ldsrc, int K, bf16* WT, const float* gk, LAS float* scr, int k0, int n0src, int n0dst, int lane) {
    float wv[32];
#pragma unroll
    for (int i = 0; i < 32; ++i) { const int kk = 2 * i + (lane >> 5); wv[i] = W[(size_t)(k0 + kk) * ldsrc + n0src + (lane & 31)]; }
    if (gk) {
#pragma unroll
        for (int i = 0; i < 32; ++i) wv[i] *= gk[k0 + 2 * i + (lane >> 5)]; }
#pragma unroll
    for (int i = 0; i < 32; ++i) { const int kk = 2 * i + (lane >> 5); scr[kk * 33 + (lane & 31)] = wv[i]; }
    LDS_WAIT(); asm volatile("" ::: "memory");
    const int c = lane & 7;
#pragma unroll
    for (int j = 0; j < 4; ++j) { const int n = (lane >> 3) + 8 * j; const LAS float* s = scr + (8 * c) * 33 + n;
        u32x4 o; o.x = pk2(s[0 * 33], s[1 * 33]); o.y = pk2(s[2 * 33], s[3 * 33]); o.z = pk2(s[4 * 33], s[5 * 33]); o.w = pk2(s[6 * 33], s[7 * 33]);
        *(u32x4*)(WT + (size_t)(n0dst + n) * K + k0 + 8 * c) = o; }
    LDS_WAIT(); asm volatile("" ::: "memory");
}
__device__ __forceinline__ float logsigmoidf_(float x) { return fminf(x, 0.f) - log1pf(__expf(-fabsf(x))); }

__device__ __forceinline__ void p0_prologue(const Args& a, LAS unsigned char* lds, int tid, int lane, int wave, int bid, int G) {
    unsigned char* ws = a.ws;
    const float* win = a.in[I_WIN]; const float* g1 = a.in[I_G1];
    LAS bf16* WGB = (LAS bf16*)lds;
    { float wv[16], gv[16];
#pragma unroll
      for (int i = 0; i < 16; ++i) { const int idx = tid + NTHREADS * i, k = idx >> 3, c = idx & 7; wv[i] = win[(size_t)k * NIN + 2048 + c]; gv[i] = g1[k]; }
#pragma unroll
      for (int i = 0; i < 16; ++i) { const int idx = tid + NTHREADS * i, k = idx >> 3, c = idx & 7; WGB[c * 1032 + k] = (bf16)(pk2(wv[i] * gv[i], 0.f) & 0xffffu); }
      for (int i = tid; i < 8 * 1032 / 2; i += NTHREADS) ((LAS unsigned*)(WGB + 8 * 1032))[i] = 0u; }
    __syncthreads();
    const int gw = bid * NWAVES + wave, NGW = G * NWAVES;
    if (wave >= 4) {
        LAS float* scr = (LAS float*)(lds + 40960 + (wave - 4) * 8448);
        const int tw = bid * 4 + (wave - 4), NTW = G * 4;
        constexpr int I1 = 16 * 96, I2 = 16 * 32, I3 = 16 * 64;
        for (int it = tw; it < I1 + I2 + I3; it += NTW) {
            int r = it;
            if (r < I1) { const int kb = r / 96, nb = r % 96, n0 = 32 * nb; transpose_item(win, NIN, DM, (bf16*)(ws + WS_W1T), g1, scr, 64 * kb, n0 + (n0 >= 2048 ? 8 : 0), n0, lane); continue; } r -= I1;
            if (r < I2) { const int kb = r / 32, nb = r % 32; transpose_item(a.in[I_WOUT], DM, DM, (bf16*)(ws + WS_WOT), nullptr, scr, 64 * kb, 32 * nb, 32 * nb, lane); continue; } r -= I2;
            { const int kb = r / 64, nb = r % 64; transpose_item(a.in[I_WQ], 2048, DM, (bf16*)(ws + WS_WQT), a.in[I_G2], scr, 64 * kb, 32 * nb, 32 * nb, lane); }
        }
        { const f32x4* src = (const f32x4*)a.in[I_SK]; u32x2* dst = (u32x2*)(ws + WS_SKB);
          for (int i = tw * 64 + lane; i < PH * 2 * PKEYS * 128 / 4; i += NTW * 64) { const f32x4 v = src[i]; u32x2 o; o.x = pk2(v[0], v[1]); o.y = pk2(v[2], v[3]); dst[i] = o; } }
    } else {
        const float* x = a.in[I_X]; bf16* XB = (bf16*)(ws + WS_XB); float* rs1 = (float*)(ws + WS_RS1); float* LF = (float*)(ws + WS_LF); float* IG = (float*)(ws + WS_IG);
        const int fr = lane & 15, fq = lane >> 4;
        f32x4 bias = (f32x4){0.f, 0.f, 0.f, 0.f};
        if (fq == 0) bias = *(const f32x4*)a.in[I_BI]; else if (fq == 1) bias = *(const f32x4*)a.in[I_BF];
        for (int task = bid * 4 + wave; task < T / 16; task += G * 4) {
            const int m = 16 * task + fr; const float* xr = x + (size_t)m * DM + 8 * fq; bf16* xo = XB + (size_t)m * DM + 8 * fq;
            f32x4 acc = (f32x4){0.f, 0.f, 0.f, 0.f}; float ss = 0.f;
#pragma unroll 8
            for (int kk = 0; kk < 32; ++kk) {
                const f32x4 a0 = *(const f32x4*)(xr + 32 * kk), a1 = *(const f32x4*)(xr + 32 * kk + 4);
                ss += ((a0[0] * a0[0] + a0[1] * a0[1]) + (a0[2] * a0[2] + a0[3] * a0[3])) + ((a1[0] * a1[0] + a1[1] * a1[1]) + (a1[2] * a1[2] + a1[3] * a1[3]));
                u32x4 w; w.x = pk2(a0[0], a0[1]); w.y = pk2(a0[2], a0[3]); w.z = pk2(a1[0], a1[1]); w.w = pk2(a1[2], a1[3]);
                *(u32x4*)(xo + 32 * kk) = w;
                acc = MMA16(ldfrag(WGB, 1032, 0, 32 * kk, lane), __builtin_bit_cast(bf16x8, w), acc);
            }
            ss += __shfl_xor(ss, 16); ss += __shfl_xor(ss, 32);
            const float rs = rsqrtf(ss * (1.f / DM) + EPS);
            const int b = m >> 12, sq = m & (SEQ - 1);
            if (fq == 0) { rs1[m] = rs;
#pragma unroll
                for (int i = 0; i < 4; ++i) IG[(size_t)(b * NH + i) * SEQ + sq] = acc[i] * rs + bias[i]; }
            else if (fq == 1) {
#pragma unroll
                for (int i = 0; i < 4; ++i) LF[(size_t)(b * NH + i) * SEQ + sq] = logsigmoidf_(acc[i] * rs + bias[i]); }
        }
    }
}

__device__ __forceinline__ void p1_stats(const Args& a, int lane, int gw) {
    if (gw >= NBH * NCH) return;
    unsigned char* ws = a.ws; const int bh = gw >> 6, c = gw & 63; const size_t o = (size_t)bh * SEQ + c * 64 + lane;
    float b = ((const float*)(ws + WS_LF))[o];
#pragma unroll
    for (int d = 1; d < 64; d <<= 1) { const float t = __shfl_up(b, d); if (lane >= d) b += t; }
    const float av = ((const float*)(ws + WS_IG))[o] - b;
    ((float*)(ws + WS_BC))[o] = b; ((float*)(ws + WS_AV))[o] = av;
    const float bL = __shfl(b, 63), am = wave_max(av);
    if (lane == 0) { ((float*)(ws + WS_BL))[gw] = bL; ((float*)(ws + WS_AM))[gw] = am; }
}
__device__ __forceinline__ float m_scan_excl(const float* bL, const float* am, int bh, int lane) {
    float A = bL[bh * 64 + lane], B = am[bh * 64 + lane] + A;
#pragma unroll
    for (int d = 1; d < 64; d <<= 1) { const float Ap = __shfl_up(A, d), Bp = __shfl_up(B, d); if (lane >= d) { B = fmaxf(Bp + A, B); A = Ap + A; } }
    const float m = fmaxf(A, B);
    const float mp = __shfl_up(m, 1); return lane == 0 ? 0.f : mp;
}
__device__ __forceinline__ float m_prev_of(const float* bL, const float* am, int bh, int c) {
    return __shfl(m_scan_excl(bL, am, bh, (int)(threadIdx.x & 63)), c);
}

struct ConvIn { u32x4 x[5]; f32x4 w[8]; f32x4 b[2]; };
__device__ __forceinline__ void conv_load(ConvIn& C, const bf16* Z, const float* cw, const float* cb, int tok0, int sloc0, int r0, int ch0) {
#pragma unroll
    for (int j = 0; j < 4; ++j) { C.w[2 * j] = *(const f32x4*)(cw + j * 1024 + ch0); C.w[2 * j + 1] = *(const f32x4*)(cw + j * 1024 + ch0 + 4); }
    C.b[0] = *(const f32x4*)(cb + ch0); C.b[1] = *(const f32x4*)(cb + ch0 + 4);
#pragma unroll
    for (int i = 0; i < 5; ++i) { const int sr = r0 - 3 + i; const bool ok = sloc0 + sr >= 0; const u32x4 q = *(const u32x4*)(Z + (size_t)(tok0 + (ok ? sr : 0)) * NZ + ch0);
        C.x[i] = ok ? q : (u32x4){0u, 0u, 0u, 0u}; }
}
__device__ __forceinline__ void conv_compute(const ConvIn& C, float (&o)[2][8]) {
    float xv[5][8];
#pragma unroll
    for (int i = 0; i < 5; ++i) { const u32x4 q = C.x[i]; xv[i][0] = bflo(q.x); xv[i][1] = bfhi(q.x); xv[i][2] = bflo(q.y); xv[i][3] = bfhi(q.y); xv[i][4] = bflo(q.z); xv[i][5] = bfhi(q.z); xv[i][6] = bflo(q.w); xv[i][7] = bfhi(q.w); }
#pragma unroll
    for (int r = 0; r < 2; ++r)
#pragma unroll
        for (int e = 0; e < 8; ++e) { float acc = C.b[e >> 2][e & 3];
#pragma unroll
            for (int j = 0; j < 4; ++j) acc += C.w[2 * j + (e >> 2)][e & 3] * xv[r + j][e];
            o[r][e] = siluf_(acc); }
}

__device__ __forceinline__ void p2_dc_task(const Args& a, LAS unsigned char* lds, int tid, int lane, int wave, int task) {
    unsigned char* ws = a.ws; const bf16* Z = (const bf16*)(ws + WS_Z);
    const int bh = task >> 6, c = task & 63, b = bh >> 2, h = bh & 3, tok0 = b * SEQ + c * 64;
    const float* AV = (const float*)(ws + WS_AV) + (size_t)bh * SEQ + c * 64;
    const float mp = m_prev_of((const float*)(ws + WS_BL), (const float*)(ws + WS_AM), bh, c);
    const float M63 = fmaxf(mp, ((const float*)(ws + WS_AM))[bh * 64 + c]);
    LAS bf16* KT = (LAS bf16*)lds; LAS bf16* VT = (LAS bf16*)(lds + 17408); LAS float* WG = (LAS float*)(lds + 34816);
    if (tid < 64) WG[tid] = __expf(AV[tid] - M63);
    const int cc = tid & 15, rp = tid >> 4, r0 = 2 * rp;
    ConvIn ck; conv_load(ck, Z, a.in[I_CW], a.in[I_CB], tok0, c * 64, r0, 512 + h * DH + 8 * cc);
    u32x4 vq[2]; float avr[2];
#pragma unroll
    for (int r = 0; r < 2; ++r) { vq[r] = *(const u32x4*)(Z + (size_t)(tok0 + r0 + r) * NZ + 1024 + h * DH + 8 * cc); avr[r] = AV[r0 + r]; }
    { float o[2][8]; conv_compute(ck, o);
#pragma unroll
      for (int r = 0; r < 2; ++r) { LAS unsigned* d = (LAS unsigned*)(KT + (r0 + r) * 136 + 8 * cc);
#pragma unroll
          for (int e = 0; e < 4; ++e) d[e] = pk2(o[r][2 * e] * 0.08838834764831845f, o[r][2 * e + 1] * 0.08838834764831845f); } }
#pragma unroll
    for (int r = 0; r < 2; ++r) { const float wg = __expf(avr[r] - M63);
        const u32x4 q = vq[r];
        LAS unsigned* d = (LAS unsigned*)(VT + (r0 + r) * 136 + 8 * cc);
        d[0] = pk2(bflo(q.x) * wg, bfhi(q.x) * wg); d[1] = pk2(bflo(q.y) * wg, bfhi(q.y) * wg); d[2] = pk2(bflo(q.z) * wg, bfhi(q.z) * wg); d[3] = pk2(bflo(q.w) * wg, bfhi(q.w) * wg); }
    __syncthreads();
    f32x4 acc[8];
#pragma unroll
    for (int n = 0; n < 8; ++n) acc[n] = (f32x4){0.f, 0.f, 0.f, 0.f};
#pragma unroll
    for (int kk = 0; kk < 2; ++kk) { const bf16x8 mf = ldfragT(VT, 136, 16 * wave, 32 * kk, lane);
#pragma unroll
        for (int n = 0; n < 8; ++n) { const bf16x8 nf = ldfragT(KT, 136, 16 * n, 32 * kk, lane); acc[n] = MMA16(nf, mf, acc[n]); } }
    bf16* DC = (bf16*)(ws + WS_DC) + ((size_t)task * DH + 16 * wave + (lane & 15)) * DH + 4 * (lane >> 4);
#pragma unroll
    for (int n = 0; n < 8; ++n) { u32x2 o; o.x = pk2(acc[n][0], acc[n][1]); o.y = pk2(acc[n][2], acc[n][3]); *(u32x2*)(DC + 16 * n) = o; }
    if (tid < DH) { float s = 0.f;
#pragma unroll 8
        for (int r = 0; r < 64; ++r) s += WG[r] * bf2f(KT[r * 136 + tid]);
        ((float*)(ws + WS_DN))[(size_t)task * DH + tid] = s; }
    __syncthreads();
}

__device__ __forceinline__ void p2_gmlp_task(const Args& a, LAS unsigned char* lds, int tid, int lane, int wave, int task) {
    unsigned char* ws = a.ws; const bf16* Z = (const bf16*)(ws + WS_Z); bf16* Y = (bf16*)(ws + WS_Y);
    const int g = task & 3, ck = (task >> 2) & 31, b = task >> 7, tok0 = b * SEQ + ck * 128;
    LAS bf16* VV = (LAS bf16*)lds; LAS bf16* WM = (LAS bf16*)(lds + 34816);
    { const int r = tid >> 2, qd = tid & 3; const bf16* src = Z + (size_t)(tok0 + r) * NZ + 2560 + g * 128 + 32 * qd; float v[32];
#pragma unroll
      for (int i = 0; i < 4; ++i) { const u32x4 q = *(const u32x4*)(src + 8 * i);
          v[8 * i + 0] = bflo(q.x); v[8 * i + 1] = bfhi(q.x); v[8 * i + 2] = bflo(q.y); v[8 * i + 3] = bfhi(q.y); v[8 * i + 4] = bflo(q.z); v[8 * i + 5] = bfhi(q.z); v[8 * i + 6] = bflo(q.w); v[8 * i + 7] = bfhi(q.w); }
      float s = 0.f;
#pragma unroll
      for (int i = 0; i < 32; ++i) s += v[i];
      s += __shfl_xor(s, 1); s += __shfl_xor(s, 2);
      const float mu = s * (1.f / 128.f); float q2 = 0.f;
#pragma unroll
      for (int i = 0; i < 32; ++i) { v[i] -= mu; q2 += v[i] * v[i]; }
      q2 += __shfl_xor(q2, 1); q2 += __shfl_xor(q2, 2);
      const float rstd = rsqrtf(q2 * (1.f / 128.f) + EPS);
      const float* lg = a.in[I_LNG] + g * 128 + 32 * qd; const float* lb = a.in[I_LNB] + g * 128 + 32 * qd;
      LAS unsigned* d = (LAS unsigned*)(VV + r * 136 + 32 * qd);
#pragma unroll
      for (int i = 0; i < 16; ++i) d[i] = pk2(v[2 * i] * rstd * lg[2 * i] + lb[2 * i], v[2 * i + 1] * rstd * lg[2 * i + 1] + lb[2 * i + 1]); }
    { const f32x4* wsrc = (const f32x4*)(a.in[I_WS] + (size_t)g * 128 * 128);
#pragma unroll
      for (int i = 0; i < 8; ++i) { const int idx = tid + NTHREADS * i, t = idx >> 5, s4 = (idx & 31) * 4; f32x4 w = wsrc[idx];
          if ((t >> 6) < (s4 >> 6)) w = (f32x4){0.f, 0.f, 0.f, 0.f};
          u32x2 o; o.x = pk2(w[0], w[1]); o.y = pk2(w[2], w[3]); *(LAS u32x2*)(WM + t * 136 + s4) = o; } }
    __syncthreads();
    f32x4 acc[8];
#pragma unroll
    for (int n = 0; n < 8; ++n) acc[n] = (f32x4){0.f, 0.f, 0.f, 0.f};
#pragma unroll
    for (int kk = 0; kk < 4; ++kk) { const bf16x8 mf = ldfrag(WM, 136, 16 * wave, 32 * kk, lane);
#pragma unroll
        for (int n = 0; n < 8; ++n) { const bf16x8 nf = ldfragT(VV, 136, 16 * n, 32 * kk, lane); acc[n] = MMA16(nf, mf, acc[n]); } }
    const int t = 16 * wave + (lane & 15), d0 = 4 * (lane >> 4); const float bias = a.in[I_BS][g * 128 + t];
    const bf16* up = Z + (size_t)(tok0 + t) * NZ + 2048 + g * 128 + d0; bf16* yp = Y + (size_t)(tok0 + t) * DM + 512 + g * 128 + d0;
#pragma unroll
    for (int n = 0; n < 8; ++n) { const u32x2 uq = *(const u32x2*)(up + 16 * n);
        u32x2 o; o.x = pk2(bflo(uq.x) * (acc[n][0] + bias), bfhi(uq.x) * (acc[n][1] + bias)); o.y = pk2(bflo(uq.y) * (acc[n][2] + bias), bfhi(uq.y) * (acc[n][3] + bias));
        *(u32x2*)(yp + 16 * n) = o; }
    __syncthreads();
}

__device__ __forceinline__ void p3_scan(const Args& a, LAS unsigned char* lds, int tid, int bid, int G) {
    unsigned char* ws = a.ws; const float* bL = (const float*)(ws + WS_BL); const float* am = (const float*)(ws + WS_AM);
    const unsigned* DC = (const unsigned*)(ws + WS_DC); unsigned* CP = (unsigned*)(ws + WS_CP);
    LAS float* DEC = (LAS float*)lds;
    for (int i = tid; i < NBH * 64; i += NTHREADS) { const int bh = i >> 6, c = i & 63; const float mp = m_scan_excl(bL, am, bh, c); DEC[i] = __expf(mp - fmaxf(mp, am[i])); }
    __syncthreads();
    for (int e2 = bid * NTHREADS + tid; e2 < NBH * DH * DH / 2; e2 += G * NTHREADS) {
        const int bh = e2 >> 13, el = e2 & 8191; float c0 = 0.f, c1 = 0.f;
#pragma unroll 16
        for (int c = 0; c < NCH; ++c) { const size_t o = ((size_t)(bh * NCH + c) << 13) + el;
            CP[o] = pk2(c0, c1); const unsigned d = DC[o]; const float dec = DEC[bh * 64 + c];
            c0 = dec * c0 + bflo(d); c1 = dec * c1 + bfhi(d); }
    }
    const float* DN = (const float*)(ws + WS_DN); float* NP = (float*)(ws + WS_NP);
    for (int e = bid * NTHREADS + tid; e < NBH * DH; e += G * NTHREADS) { const int bh = e >> 7, k = e & 127; float n = 0.f;
#pragma unroll 8
        for (int c = 0; c < NCH; ++c) { const size_t o = (size_t)(bh * NCH + c) * DH + k; NP[o] = n; n = DEC[bh * 64 + c] * n + DN[o]; } }
    __syncthreads();
}

__device__ __forceinline__ void p4_out_task(const Args& a, LAS unsigned char* lds, int tid, int lane, int wave, int task) {
    unsigned char* ws = a.ws; const bf16* Z = (const bf16*)(ws + WS_Z); bf16* Y = (bf16*)(ws + WS_Y);
    const int bh = task >> 6, c = task & 63, b = bh >> 2, h = bh & 3, tok0 = b * SEQ + c * 64;
    LAS bf16* QS = (LAS bf16*)lds; LAS bf16* KS = (LAS bf16*)(lds + 17408); LAS bf16* VS = (LAS bf16*)(lds + 34816); LAS bf16* CS = (LAS bf16*)(lds + 54272);
    LAS bf16* PS = (LAS bf16*)(lds + 93440); LAS float* NUM = (LAS float*)(lds + 102656); LAS float* AS = (LAS float*)(lds + 139776); LAS float* MT = AS + 64; LAS float* BT = AS + 128;
    const float mp = m_prev_of((const float*)(ws + WS_BL), (const float*)(ws + WS_AM), bh, c);
    const int cc = tid & 15, rp = tid >> 4, r0 = 2 * rp;
    ConvIn cq, ck; conv_load(cq, Z, a.in[I_CW], a.in[I_CB], tok0, c * 64, r0, h * DH + 8 * cc); conv_load(ck, Z, a.in[I_CW], a.in[I_CB], tok0, c * 64, r0, 512 + h * DH + 8 * cc);
    u32x4 vq[2], cq4[4];
#pragma unroll
    for (int r = 0; r < 2; ++r) vq[r] = *(const u32x4*)(Z + (size_t)(tok0 + r0 + r) * NZ + 1024 + h * DH + 8 * cc);
    { const u32x4* src = (const u32x4*)((const bf16*)(ws + WS_CP) + (size_t)task * DH * DH);
#pragma unroll
      for (int i = 0; i < 4; ++i) cq4[i] = src[tid + NTHREADS * i]; }
    { float o[2][8]; conv_compute(cq, o);
#pragma unroll
      for (int r = 0; r < 2; ++r) { u32x4 w; w.x = pk2(o[r][0], o[r][1]); w.y = pk2(o[r][2], o[r][3]); w.z = pk2(o[r][4], o[r][5]); w.w = pk2(o[r][6], o[r][7]); *(LAS u32x4*)(QS + (r0 + r) * 136 + 8 * cc) = w; } }
    { float o[2][8]; conv_compute(ck, o); const float sc = 0.08838834764831845f;
#pragma unroll
      for (int r = 0; r < 2; ++r) { u32x4 w; w.x = pk2(o[r][0] * sc, o[r][1] * sc); w.y = pk2(o[r][2] * sc, o[r][3] * sc); w.z = pk2(o[r][4] * sc, o[r][5] * sc); w.w = pk2(o[r][6] * sc, o[r][7] * sc); *(LAS u32x4*)(KS + (r0 + r) * 136 + 8 * cc) = w; } }
#pragma unroll
    for (int r = 0; r < 2; ++r) { const u32x4 q = vq[r];
        LAS unsigned* d = (LAS unsigned*)(VS + (r0 + r) * 152 + 8 * cc); d[0] = q.x; d[1] = q.y; d[2] = q.z; d[3] = q.w; }
    if (tid < 64) { LAS unsigned* d = (LAS unsigned*)(VS + tid * 152 + 128); d[0] = 0x00003F80u;
#pragma unroll
        for (int e = 1; e < 8; ++e) d[e] = 0u; }
#pragma unroll
    for (int i = 0; i < 4; ++i) { const int idx = tid + NTHREADS * i, v = idx >> 4, kc = idx & 15; *(LAS u32x4*)(CS + v * 136 + 8 * kc) = cq4[i]; }
    if (tid < DH) CS[128 * 136 + tid] = (bf16)(pk2(((const float*)(ws + WS_NP))[(size_t)task * DH + tid], 0.f) & 0xffffu);
    for (int i = tid; i < 15 * 68; i += NTHREADS) ((LAS unsigned*)(CS + 129 * 136))[i] = 0u;
    if (tid < 64) { const size_t o = (size_t)bh * SEQ + c * 64 + tid; const float av = ((const float*)(ws + WS_AV))[o]; float pm = av;
#pragma unroll
        for (int d = 1; d < 64; d <<= 1) { const float t = __shfl_up(pm, d); if (lane >= d) pm = fmaxf(pm, t); }
        AS[tid] = av; MT[tid] = fmaxf(mp, pm); BT[tid] = ((const float*)(ws + WS_BC))[o]; }
    __syncthreads();
    const int fr = lane & 15, fq = lane >> 4, mt = wave & 3, hf = wave >> 2, t = 16 * mt + fr;
    {
        const float Mt = MT[t];
#pragma unroll
        for (int nn = 0; nn < 2; ++nn) { const int nt = 2 * hf + nn; f32x4 acc = (f32x4){0.f, 0.f, 0.f, 0.f};
#pragma unroll
            for (int kk = 0; kk < 4; ++kk) acc = MMA16(ldfrag(KS, 136, 16 * nt, 32 * kk, lane), ldfrag(QS, 136, 16 * mt, 32 * kk, lane), acc);
            float p[4];
#pragma unroll
            for (int i = 0; i < 4; ++i) { const int s = 16 * nt + 4 * fq + i; p[i] = (s <= t) ? acc[i] * __expf(AS[s] - Mt) : 0.f; }
            u32x2 o; o.x = pk2(p[0], p[1]); o.y = pk2(p[2], p[3]); *(LAS u32x2*)(PS + t * 72 + 16 * nt + 4 * fq) = o; }
    }
    __syncthreads();
    {
        const int n0 = hf ? 5 : 0, cnt = hf ? 4 : 5;
        f32x4 a1[5], a2[5];
#pragma unroll
        for (int nn = 0; nn < 5; ++nn) { a1[nn] = (f32x4){0.f, 0.f, 0.f, 0.f}; a2[nn] = (f32x4){0.f, 0.f, 0.f, 0.f}; }
#pragma unroll
        for (int kk = 0; kk < 2; ++kk) { const bf16x8 mf = ldfrag(PS, 72, 16 * mt, 32 * kk, lane);
#pragma unroll
            for (int nn = 0; nn < 5; ++nn) if (nn < cnt) a1[nn] = MMA16(ldfragT(VS, 152, 16 * (n0 + nn), 32 * kk, lane), mf, a1[nn]); }
#pragma unroll
        for (int kk = 0; kk < 4; ++kk) { const bf16x8 mf = ldfrag(QS, 136, 16 * mt, 32 * kk, lane);
#pragma unroll
            for (int nn = 0; nn < 5; ++nn) if (nn < cnt) a2[nn] = MMA16(ldfrag(CS, 136, 16 * (n0 + nn), 32 * kk, lane), mf, a2[nn]); }
        const float sc = __expf(mp - MT[t]);
#pragma unroll
        for (int nn = 0; nn < 5; ++nn) if (nn < cnt) {
#pragma unroll
            for (int i = 0; i < 4; ++i) NUM[t * 145 + 16 * (n0 + nn) + 4 * fq + i] = a1[nn][i] + sc * a2[nn][i]; }
    }
    __syncthreads();
    {
        const int rr = lane >> 3, cq = lane & 7, tt = 8 * wave + rr; const size_t tok = (size_t)(tok0 + tt);
        const u32x4 oa = *(const u32x4*)(Z + tok * NZ + 1536 + h * DH + 16 * cq), ob = *(const u32x4*)(Z + tok * NZ + 1536 + h * DH + 16 * cq + 8);
        const float* ng = a.in[I_MNG] + h * DH + 16 * cq; f32x4 ngv[4];
#pragma unroll
        for (int j = 0; j < 4; ++j) ngv[j] = ((const f32x4*)ng)[j];
        const float den = NUM[tt * 145 + 128]; const float inv = 1.f / fmaxf(fabsf(den), __expf(-(BT[tt] + MT[tt])));
        float hv[16]; float ss = 0.f;
#pragma unroll
        for (int i = 0; i < 16; ++i) { hv[i] = NUM[tt * 145 + 16 * cq + i] * inv; ss += hv[i] * hv[i]; }
        ss += __shfl_xor(ss, 1); ss += __shfl_xor(ss, 2); ss += __shfl_xor(ss, 4);
        const float r = rsqrtf(ss * (1.f / DH) + EPS);
        float ov[16];
#pragma unroll
        for (int w = 0; w < 4; ++w) { ov[2 * w] = bflo(oa[w]); ov[2 * w + 1] = bfhi(oa[w]); ov[8 + 2 * w] = bflo(ob[w]); ov[8 + 2 * w + 1] = bfhi(ob[w]); }
        float y[16];
#pragma unroll
        for (int i = 0; i < 16; ++i) y[i] = hv[i] * r * ngv[i >> 2][i & 3] * sigmoidf_(ov[i]);
        u32x4 w0, w1;
#pragma unroll
        for (int w = 0; w < 4; ++w) { w0[w] = pk2(y[2 * w], y[2 * w + 1]); w1[w] = pk2(y[8 + 2 * w], y[8 + 2 * w + 1]); }
        bf16* yp = Y + tok * DM + h * DH + 16 * cq; *(u32x4*)yp = w0; *(u32x4*)(yp + 8) = w1;
    }
    __syncthreads();
}

struct TabRow { f32x4 v[4]; };
typedef int i32x2_t __attribute__((ext_vector_type(2)));
__device__ __forceinline__ void tab_load(const Args& a, int row, int lane, TabRow& R) {
    const bool isv = row >= NEXP; const int e = row & (NEXP - 1);
    const f32x4* src = (const f32x4*)((isv ? a.in[I_PV] : a.in[I_PU]) + (size_t)e * DM) + (isv ? 64 * (lane >> 4) + (lane & 15) : 4 * lane);
    const int st = isv ? 16 : 1;
#pragma unroll
    for (int j = 0; j < 4; ++j) R.v[j] = src[j * st];
}
__device__ __forceinline__ unsigned i4x8(const f32x4 a, const f32x4 b, float inv) {
    unsigned r = 0u;
#pragma unroll
    for (int k = 0; k < 8; ++k) { const float v = (k < 4 ? a[k & 3] : b[k & 3]) * inv; const unsigned bits = __float_as_uint(__builtin_amdgcn_fmed3f(v, -8.f, 7.f) + 12582912.f); r |= (bits & 15u) << (4 * k); }
    return r;
}
__device__ __forceinline__ void tab_finish(const Args& a, int row, int lane, TabRow& R, LAS unsigned char* tsc) {
    unsigned char* ws = a.ws; const bool isv = row >= NEXP; const int e = row & (NEXP - 1); float am = 0.f, sq = 0.f;
#pragma unroll
    for (int j = 0; j < 4; ++j) { if (!isv) R.v[j] = R.v[j] * ((const f32x4*)a.in[I_G2])[4 * lane + j]; am = fmaxf(am, fmaxf(fmaxf(fabsf(R.v[j][0]), fabsf(R.v[j][1])), fmaxf(fabsf(R.v[j][2]), fabsf(R.v[j][3]))));
        sq += (R.v[j][0] * R.v[j][0] + R.v[j][1] * R.v[j][1]) + (R.v[j][2] * R.v[j][2] + R.v[j][3] * R.v[j][3]); }
    am = wave_max(am);
    u32x2 o; float sc;
    if (isv) {
        sc = am > 0.f ? am * (1.f / 6.f) : 1.f; const float inv = 1.f / sc;
        unsigned r = 0u;
        r = __builtin_amdgcn_cvt_scalef32_pk_fp4_f32(r, R.v[0][0] * inv, R.v[0][1] * inv, 1.0f, 0); r = __builtin_amdgcn_cvt_scalef32_pk_fp4_f32(r, R.v[0][2] * inv, R.v[0][3] * inv, 1.0f, 1);
        r = __builtin_amdgcn_cvt_scalef32_pk_fp4_f32(r, R.v[1][0] * inv, R.v[1][1] * inv, 1.0f, 2); r = __builtin_amdgcn_cvt_scalef32_pk_fp4_f32(r, R.v[1][2] * inv, R.v[1][3] * inv, 1.0f, 3); o[0] = r; r = 0u;
        r = __builtin_amdgcn_cvt_scalef32_pk_fp4_f32(r, R.v[2][0] * inv, R.v[2][1] * inv, 1.0f, 0); r = __builtin_amdgcn_cvt_scalef32_pk_fp4_f32(r, R.v[2][2] * inv, R.v[2][3] * inv, 1.0f, 1);
        r = __builtin_amdgcn_cvt_scalef32_pk_fp4_f32(r, R.v[3][0] * inv, R.v[3][1] * inv, 1.0f, 2); r = __builtin_amdgcn_cvt_scalef32_pk_fp4_f32(r, R.v[3][2] * inv, R.v[3][3] * inv, 1.0f, 3); o[1] = r;
        *(LAS u32x2*)(tsc + 8 * lane) = o;
        const auto tr = __builtin_amdgcn_ds_read_tr4_b64_v2i32((LAS i32x2_t*)(tsc + 8 * lane));
        o[0] = (unsigned)tr[0]; o[1] = (unsigned)tr[1];
    } else {
        sq = wave_sum(sq); sc = fminf(am * (1.f / 7.f), 0.345f * sqrtf(sq * (1.f / DM))); sc = sc > 0.f ? sc : 1.f; const float inv = 1.f / sc;
        o[0] = i4x8(R.v[0], R.v[1], inv); o[1] = i4x8(R.v[2], R.v[3], inv);
    }
    *(u32x2*)(ws + (isv ? WS_VB : WS_UB) + (size_t)(lane >> 4) * (NEXP * 128) + (size_t)e * 128 + 8 * (lane & 15)) = o;
    if (lane == 0) ((float*)(ws + (isv ? WS_SV : WS_SU)))[e] = sc;
}

template <int N> __device__ __forceinline__ void bitonic_sort_desc(float (&v)[N]) {
#pragma unroll
    for (int k = 2; k <= N; k <<= 1)
#pragma unroll
        for (int j = k >> 1; j > 0; j >>= 1)
#pragma unroll
            for (int i = 0; i < N; ++i) { const int l = i ^ j; if (l > i) { const float mx = fmaxf(v[i], v[l]), mn = fminf(v[i], v[l]); if ((i & k) == 0) { v[i] = mx; v[l] = mn; } else { v[i] = mn; v[l] = mx; } } }
}
__device__ __forceinline__ void merge_top16(float (&a)[16], const float (&b)[16]) {
#pragma unroll
    for (int i = 0; i < 16; ++i) a[i] = fmaxf(a[i], b[15 - i]);
#pragma unroll
    for (int j = 8; j > 0; j >>= 1)
#pragma unroll
        for (int i = 0; i < 16; ++i) { const int l = i ^ j; if (l > i) { const float mx = fmaxf(a[i], a[l]), mn = fminf(a[i], a[l]); a[i] = mx; a[l] = mn; } }
}
constexpr int P7_SK = 0, P7_QS = 69632, P7_LS = P7_QS + 64 * 264 * 2, P7_OS = P7_LS + 64 * 33 * 4, P7_OE = P7_OS + 64 * 16 * 4, P7_END = P7_OE + 64 * 16 * 4;
constexpr int P7_TS = P7_END;
static_assert(P7_TS + 4 * 512 <= LDSCTL_OFF, "P7 LDS map");
__device__ __forceinline__ void p7_topk(const Args& a, LAS unsigned char* lds, int tid, int lane, int wave, int bid, int G) {
    unsigned char* ws = a.ws; const bf16* Q = (const bf16*)(ws + WS_Q);
    const int h = bid & 7, slot = bid >> 3, nslot = G >> 3;
    LAS bf16* SK = (LAS bf16*)(lds + P7_SK); LAS bf16* QS = (LAS bf16*)(lds + P7_QS); LAS float* LS = (LAS float*)(lds + P7_LS);
    { const u32x4* src = (const u32x4*)((const bf16*)(ws + WS_SKB) + (size_t)h * 2 * PKEYS * 128);
#pragma unroll
      for (int i = 0; i < 8; ++i) { const int idx = tid + NTHREADS * i, r = idx >> 4, cc = idx & 15; *(LAS u32x4*)(SK + r * 136 + 8 * cc) = src[idx]; } }
    const int fr = lane & 15, fq = lane >> 4, mt = wave & 3, p = wave >> 2;
    LAS unsigned char* tsc = lds + P7_TS + 512 * (wave & 3);
    constexpr int TCH = 8;
    const int tstride = TCH * G * 4; int it = 0;
    u32x4 qpre[4];
    if (slot < T / 64) {
#pragma unroll
        for (int i = 0; i < 4; ++i) { const int idx = tid + NTHREADS * i, r = idx >> 5, cc = idx & 31; qpre[i] = *(const u32x4*)(Q + (size_t)(slot * 64 + r) * 2048 + h * PQD + 8 * cc); } }
    for (int tile = slot; tile < T / 64; tile += nslot, ++it) {
        const int tokb = tile * 64;
#pragma unroll
        for (int i = 0; i < 4; ++i) { const int idx = tid + NTHREADS * i, r = idx >> 5, cc = idx & 31; *(LAS u32x4*)(QS + r * 264 + 8 * cc) = qpre[i]; }
        __syncthreads();
        if (tile + nslot < T / 64) {
#pragma unroll
            for (int i = 0; i < 4; ++i) { const int idx = tid + NTHREADS * i, r = idx >> 5, cc = idx & 31; qpre[i] = *(const u32x4*)(Q + (size_t)((tile + nslot) * 64 + r) * 2048 + h * PQD + 8 * cc); } }
        const int trow0 = (it * G + bid) * 4 + (wave - 4); TabRow tr0, tr1, tr2, tr3;
        const bool tdo = wave >= 4 && it < TCH;
        if (tdo) { if (trow0 < 2 * NEXP) tab_load(a, trow0, lane, tr0); if (trow0 + tstride < 2 * NEXP) tab_load(a, trow0 + tstride, lane, tr1); if (trow0 + 2 * tstride < 2 * NEXP) tab_load(a, trow0 + 2 * tstride, lane, tr2);
                   if (trow0 + 3 * tstride < 2 * NEXP) tab_load(a, trow0 + 3 * tstride, lane, tr3); }
        {
            f32x4 acc[8];
#pragma unroll
            for (int n = 0; n < 8; ++n) acc[n] = (f32x4){0.f, 0.f, 0.f, 0.f};
#pragma unroll
            for (int kk = 0; kk < 4; ++kk) { const bf16x8 mf = ldfrag(QS, 264, 16 * mt, 128 * p + 32 * kk, lane);
#pragma unroll
                for (int n = 0; n < 8; ++n) acc[n] = MMA16(ldfrag(SK + p * 128 * 136, 136, 16 * n, 32 * kk, lane), mf, acc[n]); }
            float v[32];
#pragma unroll
            for (int n = 0; n < 8; ++n)
#pragma unroll
                for (int i = 0; i < 4; ++i) v[4 * n + i] = __uint_as_float((__float_as_uint(acc[n][i]) & 0xffffff80u) | (unsigned)(16 * n + 4 * fq + i));
            bitonic_sort_desc<32>(v);
            float top[16], oth[16];
#pragma unroll
            for (int i = 0; i < 16; ++i) top[i] = v[i];
#pragma unroll
            for (int i = 0; i < 16; ++i) oth[i] = __shfl_xor(top[i], 16);
            merge_top16(top, oth);
#pragma unroll
            for (int i = 0; i < 16; ++i) oth[i] = __shfl_xor(top[i], 32);
            merge_top16(top, oth);
            if (fq == 0) {
#pragma unroll
                for (int i = 0; i < 16; ++i) LS[(16 * mt + fr) * 33 + p * 16 + i] = top[i]; }
        }
        __syncthreads();
        if (tdo) { if (trow0 < 2 * NEXP) tab_finish(a, trow0, lane, tr0, tsc); if (trow0 + tstride < 2 * NEXP) tab_finish(a, trow0 + tstride, lane, tr1, tsc); if (trow0 + 2 * tstride < 2 * NEXP) tab_finish(a, trow0 + 2 * tstride, lane, tr2, tsc);
                   if (trow0 + 3 * tstride < 2 * NEXP) tab_finish(a, trow0 + 3 * tstride, lane, tr3, tsc); }
        if (wave < 4) {
            const int tl = 16 * wave + (lane >> 2), u = lane & 3;
            const LAS float* L1 = LS + tl * 33; const LAS float* L2 = L1 + 16; LAS float* OS = (LAS float*)(lds + P7_OS) + tl * 16; LAS int* OE = (LAS int*)(lds + P7_OE) + tl * 16;
            float s1v[4], hd[4], k2c[4]; int bpk = 0; const float s20 = L2[0];
#pragma unroll
            for (int j = 0; j < 4; ++j) { s1v[j] = L1[u + 4 * j]; k2c[j] = s20; hd[j] = s1v[j] + s20; }
#pragma unroll 1
            for (int r = 0; r < 16; ++r) {
                const float lm = fmaxf(fmaxf(hd[0], hd[1]), fmaxf(hd[2], hd[3]));
                const int jl = hd[0] == lm ? 0 : hd[1] == lm ? 1 : hd[2] == lm ? 2 : 3;
                float m = fmaxf(lm, __int_as_float(__builtin_amdgcn_mov_dpp(__float_as_int(lm), 0xB1, 0xf, 0xf, true)));
                m = fmaxf(m, __int_as_float(__builtin_amdgcn_mov_dpp(__float_as_int(m), 0x4E, 0xf, 0xf, true)));
                int f = (lm == m) ? u : 4; f = min(f, __builtin_amdgcn_mov_dpp(f, 0xB1, 0xf, 0xf, true)); f = min(f, __builtin_amdgcn_mov_dpp(f, 0x4E, 0xf, 0xf, true));
                if (f == u) {
                    const int b = (bpk >> (8 * jl)) & 255, nb = b + 1, av = u + 4 * jl;
                    const float k1 = jl == 0 ? s1v[0] : jl == 1 ? s1v[1] : jl == 2 ? s1v[2] : s1v[3], k2 = jl == 0 ? k2c[0] : jl == 1 ? k2c[1] : jl == 2 ? k2c[2] : k2c[3];
                    OS[r] = m; OE[r] = (int)(__float_as_uint(k1) & 127u) * PKEYS + (int)(__float_as_uint(k2) & 127u);
                    const bool ok = (av + 1) * (nb + 1) <= 16; const float k2n = L2[ok ? nb : 0]; const float nv = ok ? k1 + k2n : -INFINITY;
                    bpk += 1 << (8 * jl);
#pragma unroll
                    for (int j = 0; j < 4; ++j) { hd[j] = (j == jl) ? nv : hd[j]; k2c[j] = (j == jl) ? k2n : k2c[j]; }
                }
            }
            const f32x4 sv = *(const LAS f32x4*)(OS + 4 * u); const float mx = OS[0];
            f32x4 ev; float sum = 0.f;
#pragma unroll
            for (int i = 0; i < 4; ++i) { ev[i] = __expf(sv[i] - mx); sum += ev[i]; }
            sum += __int_as_float(__builtin_amdgcn_mov_dpp(__float_as_int(sum), 0xB1, 0xf, 0xf, true)); sum += __int_as_float(__builtin_amdgcn_mov_dpp(__float_as_int(sum), 0x4E, 0xf, 0xf, true));
            const float inv = 1.f / sum; const size_t o = (size_t)(tokb + tl) * 128 + h * 16 + 4 * u;
            *(u32x4*)((int*)(ws + WS_IDX) + o) = *(const LAS u32x4*)(OE + 4 * u);
            *(f32x4*)((float*)(ws + WS_GATE) + o) = ev * inv;
        }
    }
    if (wave >= 4) for (; it < TCH; ++it) { const int trow0 = (it * G + bid) * 4 + (wave - 4);
        for (int row = trow0; row < 2 * NEXP; row += tstride) { TabRow tr; tab_load(a, row, lane, tr); tab_finish(a, row, lane, tr, tsc); } }
    if (wave >= 4 && 4 * tstride < 2 * NEXP) for (int it2 = 0; it2 < TCH; ++it2)
        for (int row = (it2 * G + bid) * 4 + (wave - 4) + 4 * tstride; row < 2 * NEXP; row += tstride) { TabRow tr; tab_load(a, row, lane, tr); tab_finish(a, row, lane, tr, tsc); }
    __syncthreads();
}

struct Rows8 { u32x4 r[8]; };
template <int HB> __device__ __forceinline__ void issue8(Rows8& R, const unsigned char* ubase, unsigned loff, const u32x4 (&e)[4]) {
#pragma unroll
    for (int i = 0; i < 8; ++i) R.r[i] = *(const u32x4*)(ubase + (size_t)((e[2 * HB + (i >> 2)][i & 3] << 7) + loff));
}
__device__ __forceinline__ void fp4x8h(unsigned dw, f16x2 (&f)[4]) {
    f[0] = __builtin_amdgcn_cvt_scalef32_pk_f16_fp4(dw, 1.0f, 0); f[1] = __builtin_amdgcn_cvt_scalef32_pk_f16_fp4(dw, 1.0f, 1);
    f[2] = __builtin_amdgcn_cvt_scalef32_pk_f16_fp4(dw, 1.0f, 2); f[3] = __builtin_amdgcn_cvt_scalef32_pk_f16_fp4(dw, 1.0f, 3);
}
template <int OFF> __device__ __forceinline__ void dot8(const Rows8& R, const unsigned (&xh)[4], const unsigned (&xl)[4], int (&d)[16]) {
#pragma unroll
    for (int i = 0; i < 8; ++i) { int s = 0;
#pragma unroll
        for (int w = 0; w < 4; ++w) s = __builtin_amdgcn_sdot8((int)R.r[i][w], (int)xh[w], s, false);
        s <<= 4;
#pragma unroll
        for (int w = 0; w < 4; ++w) s = __builtin_amdgcn_sdot8((int)R.r[i][w], (int)xl[w], s, false);
        d[OFF + i] = s; }
}
template <int HB> __device__ __forceinline__ void fma8(const Rows8& R, const u32x4 (&cv)[4], f16x2 (&acch)[16]) {
#pragma unroll
    for (int i = 0; i < 8; ++i) { unsigned cb = cv[2 * HB + (i >> 2)][i & 3]; asm volatile("" : "+v"(cb)); const f16x2 c2 = __builtin_bit_cast(f16x2, cb);
#pragma unroll
        for (int w = 0; w < 4; ++w) { f16x2 f[4]; fp4x8h(R.r[i][w], f);
#pragma unroll
            for (int b = 0; b < 4; ++b) acch[4 * w + b] = __builtin_elementwise_fma(f[b], c2, acch[4 * w + b]); }
        if (i & 1) __builtin_amdgcn_sched_barrier(0); }
}
__device__ __forceinline__ void bfly32(float (&v)[32], int rank) {
#pragma unroll
    for (int j = 0; j < 16; ++j) { const auto r = __builtin_amdgcn_permlane32_swap(__float_as_uint(v[j]), __float_as_uint(v[16 + j]), false, false); v[j] = __uint_as_float(r[0]) + __uint_as_float(r[1]); }
#pragma unroll
    for (int j = 0; j < 8; ++j) { const auto r = __builtin_amdgcn_permlane16_swap(__float_as_uint(v[j]), __float_as_uint(v[8 + j]), false, false); v[j] = __uint_as_float(r[0]) + __uint_as_float(r[1]); }
    { const bool b = rank & 1;
#pragma unroll
      for (int j = 0; j < 4; ++j) { const float keep = b ? v[4 + j] : v[j], send = b ? v[j] : v[4 + j]; v[j] = keep + __int_as_float(__builtin_amdgcn_update_dpp(0, __float_as_int(send), 0x128, 0xf, 0xf, false)); } }
}
#define P8_PIN __builtin_amdgcn_sched_barrier(0)
constexpr int NSL = 4;
__device__ __forceinline__ void p8a_u(const Args& a, LAS unsigned char* lds, int lane, int wave, int bid, int G) {
    unsigned char* ws = a.ws; const int slice = bid & 3, half = (bid >> 2) & 1, wsl = (bid >> 3) * NWAVES + wave, nws = (G >> 3) * NWAVES, g = lane >> 3, q = lane & 7;
    const unsigned char* U4 = ws + WS_UB; const unsigned loff = slice * (NEXP * 128) + 16 * q; const bf16* XB1 = (const bf16*)(ws + WS_XB1) + 256 * slice + 32 * q + 4 * g; const unsigned* IDX = (const unsigned*)(ws + WS_IDX) + 16 * g;
    float* AP = (float*)(ws + WS_APART) + (size_t)slice * T * 128;
    LAS unsigned* XS = (LAS unsigned*)(lds + wave * 256);
    const int tend = (half + 1) * (T / 2);
    int t = half * (T / 2) + wsl; if (t >= tend) return;
    u32x4 e[4]; u32x2 xw = *(const u32x2*)(XB1 + (size_t)t * DM);
#pragma unroll
    for (int j = 0; j < 4; ++j) e[j] = *(const u32x4*)(IDX + (size_t)t * 128 + 4 * j);
    Rows8 A, B; issue8<0>(A, U4, loff, e);
    for (; t < tend; t += nws) {
        const int tn = (t + nws < tend) ? t + nws : t;
        u32x4 en[4];
#pragma unroll
        for (int j = 0; j < 4; ++j) en[j] = *(const u32x4*)(IDX + (size_t)tn * 128 + 4 * j);
        const u32x2 xwn = *(const u32x2*)(XB1 + (size_t)tn * DM);
        issue8<1>(B, U4, loff, e);
        P8_PIN;
        unsigned xh[4], xl[4]; float sx;
        {
            const float x0 = bflo(xw[0]), x1 = bfhi(xw[0]), x2 = bflo(xw[1]), x3 = bfhi(xw[1]);
            const float am = wave_max(fmaxf(fmaxf(fabsf(x0), fabsf(x1)), fmaxf(fabsf(x2), fabsf(x3))));
            sx = am > 0.f ? am * (1.f / 119.f) : 1.f; const float inv = __builtin_amdgcn_rcpf(sx); constexpr float MG = 12582912.f + 8.f;
            const unsigned u0 = __float_as_uint(fmaf(x0, inv, MG)), u1 = __float_as_uint(fmaf(x1, inv, MG)), u2 = __float_as_uint(fmaf(x2, inv, MG)), u3 = __float_as_uint(fmaf(x3, inv, MG));
            unsigned W = __builtin_amdgcn_perm(u1, u0, 0x0c0c0400u); W = __builtin_amdgcn_perm(u2, W, 0x0c040100u); W = __builtin_amdgcn_perm(u3, W, 0x04020100u);
            unsigned H = (W >> 4) & 0x0F0F0F0Fu, L = (W & 0x0F0F0F0Fu) ^ 0x08080808u;
            H |= H >> 4; L |= L >> 4;
            XS[8 * q + g] = __builtin_amdgcn_perm(L, H, 0x06040200u);
            const u32x4 d0 = *(const LAS u32x4*)(XS + 8 * q), d1 = *(const LAS u32x4*)(XS + 8 * q + 4);
            xh[0] = __builtin_amdgcn_perm(d0[1], d0[0], 0x05040100u); xl[0] = __builtin_amdgcn_perm(d0[1], d0[0], 0x07060302u);
            xh[1] = __builtin_amdgcn_perm(d0[3], d0[2], 0x05040100u); xl[1] = __builtin_amdgcn_perm(d0[3], d0[2], 0x07060302u);
            xh[2] = __builtin_amdgcn_perm(d1[1], d1[0], 0x05040100u); xl[2] = __builtin_amdgcn_perm(d1[1], d1[0], 0x07060302u);
            xh[3] = __builtin_amdgcn_perm(d1[3], d1[2], 0x05040100u); xl[3] = __builtin_amdgcn_perm(d1[3], d1[2], 0x07060302u);
        }
        int d[16];
        dot8<0>(A, xh, xl, d);
        P8_PIN;
        issue8<0>(A, U4, loff, en);
        P8_PIN;
        dot8<8>(B, xh, xl, d);
        bfly16i<4, 2, 1>(d, q);
        *(f32x2*)(AP + (size_t)t * 128 + 16 * g + 2 * q) = (f32x2){(float)d[0] * sx, (float)d[1] * sx};
#pragma unroll
        for (int j = 0; j < 4; ++j) e[j] = en[j];
        xw = xwn;
    }
}
__device__ __forceinline__ void p8m_coef(const Args& a, int tid, int bid, int G) {
    unsigned char* ws = a.ws; const int* IDX = (const int*)(ws + WS_IDX); const float* GATE = (const float*)(ws + WS_GATE);
    const float* AP = (const float*)(ws + WS_APART); const float* SU = (const float*)(ws + WS_SU); const float* SV = (const float*)(ws + WS_SV); const float* SSP = (const float*)(ws + WS_SSP);
    unsigned char* C8 = ws + WS_COEF; float* OS = (float*)(ws + WS_COEF_OS);
    for (int i = bid * NTHREADS + tid; i < T * NSL; i += G * NTHREADS) ((unsigned*)(ws + WS_SSP2))[i] = 0xFFFFFFFFu;
    constexpr int NIT = 4; const int stride = G * NTHREADS;
    for (int i0 = bid * NTHREADS + tid; i0 < T * 32; i0 += NIT * stride) {
        f32x4 s[NIT]; u32x4 e[NIT]; f32x4 gt[NIT]; float rs2[NIT], su[NIT][4], sv[NIT][4];
#pragma unroll
        for (int j = 0; j < NIT; ++j) { const int i = min(i0 + j * stride, T * 32 - 1);
            e[j] = ((const u32x4*)IDX)[i]; gt[j] = ((const f32x4*)GATE)[i]; s[j] = ((const f32x4*)AP)[i];
#pragma unroll
            for (int sl = 1; sl < NSL; ++sl) s[j] += ((const f32x4*)(AP + (size_t)sl * T * 128))[i];
            rs2[j] = row_rs2(SSP, i >> 5); }
#pragma unroll
        for (int j = 0; j < NIT; ++j)
#pragma unroll
            for (int u = 0; u < 4; ++u) { su[j][u] = SU[e[j][u]]; sv[j][u] = SV[e[j][u]]; }
#pragma unroll
        for (int j = 0; j < NIT; ++j) { const int i = i0 + j * stride; if (i >= T * 32) break;
            const int t = i >> 5, k = i & 31;
            float c[4]; float cm = 0.f;
#pragma unroll
            for (int u = 0; u < 4; ++u) { c[u] = gelu_tanh(rs2[j] * su[j][u] * s[j][u]) * gt[j][u] * sv[j][u]; cm = fmaxf(cm, fabsf(c[u])); }
            cm = fmaxf(cm, __shfl_xor(cm, 1)); cm = fmaxf(cm, __shfl_xor(cm, 2)); cm = fmaxf(cm, __shfl_xor(cm, 4)); cm = fmaxf(cm, __shfl_xor(cm, 8)); cm = fmaxf(cm, __shfl_xor(cm, 16));
            const float sc = cm > 0.f ? 240.f / cm : 1.f;
            unsigned char* dst = C8 + (size_t)t * 384 + 32 * (k >> 3) + (k & 7);
#pragma unroll
            for (int u = 0; u < 4; ++u) { float v = c[u] * sc;
                const int p0 = __builtin_amdgcn_cvt_pk_fp8_f32(v, 0.f, 0, false); v -= __builtin_amdgcn_cvt_f32_fp8(p0, 0);
                const int p1 = __builtin_amdgcn_cvt_pk_fp8_f32(v, 0.f, 0, false); v -= __builtin_amdgcn_cvt_f32_fp8(p1, 0);
                const int p2 = __builtin_amdgcn_cvt_pk_fp8_f32(v, 0.f, 0, false);
                dst[8 * u] = (unsigned char)p0; dst[128 + 8 * u] = (unsigned char)p1; dst[256 + 8 * u] = (unsigned char)p2; }
            if (k == 0) OS[t] = cm > 0.f ? cm * (1.f / 240.f) : 1.f; }
    }
}
typedef int i32x2 __attribute__((ext_vector_type(2)));
typedef int i32x8 __attribute__((ext_vector_type(8)));
__device__ __forceinline__ void v_finalize4(float* orow, unsigned* S2u, int tok, unsigned w, const float (&xp)[16], const float (&gf)[16], int lane) {
    unsigned spins = 0;
    while (!__all(w != 0xFFFFFFFFu)) { w = __hip_atomic_load(S2u + (size_t)tok * NSL + (lane & 3), __ATOMIC_RELAXED, __HIP_MEMORY_SCOPE_AGENT); if (__all(w != 0xFFFFFFFFu)) break; __builtin_amdgcn_s_sleep(2); if (++spins > (1u << 20)) break; }
    const int wi = (int)w;
    const float sm = (__int_as_float(__builtin_amdgcn_mov_dpp(wi, 0x00, 0xf, 0xf, true)) + __int_as_float(__builtin_amdgcn_mov_dpp(wi, 0x55, 0xf, 0xf, true)))
                   + (__int_as_float(__builtin_amdgcn_mov_dpp(wi, 0xAA, 0xf, 0xf, true)) + __int_as_float(__builtin_amdgcn_mov_dpp(wi, 0xFF, 0xf, 0xf, true)));
    const float r = rsqrtf(sm * (1.f / DM) + EPS);
#pragma unroll
    for (int j = 0; j < 4; ++j) ((f32x4*)orow)[16 * j] = (f32x4){xp[4 * j] * r * gf[4 * j], xp[4 * j + 1] * r * gf[4 * j + 1], xp[4 * j + 2] * r * gf[4 * j + 2], xp[4 * j + 3] * r * gf[4 * j + 3]};
}
__device__ __forceinline__ void p8b_v(const Args& a, LAS unsigned char* lds, int lane, int wave, int bid, int G) {
    unsigned char* ws = a.ws; const int slice = bid & 3, half = (bid >> 2) & 1, wsl = (bid >> 3) * NWAVES + wave, nws = (G >> 3) * NWAVES;
    const int n = lane & 15, fq = lane >> 4, r8 = lane >> 3, c8 = lane & 7;
    LAS unsigned char* buf = lds + wave * 16384;
    const unsigned char* V4s = ws + WS_VB + (size_t)slice * (NEXP * 128) + 16 * (c8 ^ r8);
    const unsigned* IDX = (const unsigned*)(ws + WS_IDX) + 4 * r8; const unsigned char* C8 = ws + WS_COEF; const float* OS = (const float*)(ws + WS_COEF_OS);
    const bf16* XB1 = (const bf16*)(ws + WS_XB1) + 256 * slice + 4 * n; unsigned* S2u = (unsigned*)(ws + WS_SSP2);
    const int ai = n & 3, af = n >> 2;
    const bool aact = ai < 3 && (af & 1) == (fq >> 1), ahi = af >= 2;
    const unsigned aoff = ai * 128 + 16 * (fq & 1);
    const unsigned tb0 = (unsigned)(32 * fq + n) * 128u + ((unsigned)(lane & 7) << 4);
    float gf[16];
#pragma unroll
    for (int nb = 0; nb < 16; ++nb) gf[nb] = a.in[I_GF][256 * slice + 64 * (nb >> 2) + 4 * n + (nb & 3)];
    int tp = -1; float xp[16];
#pragma unroll
    for (int nb = 0; nb < 16; ++nb) xp[nb] = 0.f;
    u32x4 id[4];
    if (wsl < T / 8) {
#pragma unroll
        for (int f = 0; f < 4; ++f) id[f] = *(const u32x4*)(IDX + (size_t)(half * (T / 2) + 4 * wsl + f) * 128); }
    for (int task = wsl; task < T / 8; task += nws) {
        const int tb = half * (T / 2) + 4 * task;
        f32x4 acc[16];
#pragma unroll
        for (int nb = 0; nb < 16; ++nb) acc[nb] = (f32x4){0.f, 0.f, 0.f, 0.f};
        const int tbn = task + nws < T / 8 ? tb + 4 * nws : tb;
        u32x4 xw0 = (u32x4){0u, 0u, 0u, 0u}, xw1 = xw0; float os = 0.f; unsigned pw = 0u;
#pragma unroll 1
        for (int s = 0; s < 4; ++s) {
            asm volatile("s_waitcnt lgkmcnt(0)" ::: "memory");
#pragma unroll
            for (int ii = 0; ii < 16; ++ii)
                __builtin_amdgcn_global_load_lds((const unsigned*)(V4s + ((size_t)id[ii >> 2][ii & 3] << 7)), (LAS unsigned*)(buf + ii * 1024), 16, 0, 0);
            u32x4 idn[4];
            { const unsigned* ip = IDX + (s < 3 ? (size_t)tb * 128 + 32 * (s + 1) : (size_t)tbn * 128);
#pragma unroll
              for (int f = 0; f < 4; ++f) idn[f] = *(const u32x4*)(ip + f * 128); }
            u32x4 cvec = (u32x4){0u, 0u, 0u, 0u};
            if (aact) cvec = *(const u32x4*)(C8 + (size_t)(tb + af) * 384 + aoff + 32 * s);
            if (s == 3) { const bf16* xr = XB1 + (size_t)(tb + fq) * DM; const u32x2 q0 = *(const u32x2*)xr, q1 = *(const u32x2*)(xr + 64), q2 = *(const u32x2*)(xr + 128), q3 = *(const u32x2*)(xr + 192);
                xw0 = (u32x4){q0[0], q0[1], q1[0], q1[1]}; xw1 = (u32x4){q2[0], q2[1], q3[0], q3[1]}; os = OS[tb + fq]; }
            if (s == 0 && tp >= 0) pw = __hip_atomic_load(S2u + (size_t)(tp + fq) * NSL + (lane & 3), __ATOMIC_RELAXED, __HIP_MEMORY_SCOPE_AGENT);
            asm volatile("s_waitcnt vmcnt(0)" ::: "memory");
            i32x8 A;
#pragma unroll
            for (int w = 0; w < 4; ++w) { A[w] = ahi ? 0 : (int)cvec[w]; A[4 + w] = ahi ? (int)cvec[w] : 0; }
#pragma unroll
            for (int nb = 0; nb < 16; ++nb) {
                const unsigned ad = (tb0 ^ (unsigned)((nb >> 1) << 4)) + 8u * (nb & 1);
                const i32x2 b0 = __builtin_amdgcn_ds_read_tr4_b64_v2i32((LAS i32x2*)(buf + ad)), b1 = __builtin_amdgcn_ds_read_tr4_b64_v2i32((LAS i32x2*)(buf + ad + 16 * 128));
                const i32x8 B = {b0[0], b0[1], b1[0], b1[1], 0, 0, 0, 0};
                acc[nb] = __builtin_amdgcn_mfma_scale_f32_16x16x128_f8f6f4(A, B, acc[nb], 0, 4, 0, 0x7F7F7F7F, 0, 0x7F7F7F7F);
            }
            asm volatile("" ::: "memory");
#pragma unroll
            for (int f = 0; f < 4; ++f) id[f] = idn[f];
            if (s == 0 && tp >= 0) v_finalize4(a.out + (size_t)(tp + fq) * DM + 256 * slice + 4 * n, S2u, tp + fq, pw, xp, gf, lane);
        }
        float ss = 0.f;
#pragma unroll
        for (int nb = 0; nb < 16; ++nb) { const unsigned xw = nb < 8 ? xw0[nb >> 1] : xw1[(nb - 8) >> 1]; const float x2 = ((nb & 1) ? bfhi(xw) : bflo(xw)) + ((acc[nb][0] + acc[nb][1]) + acc[nb][2]) * os; xp[nb] = x2; ss += x2 * x2; }
        ss += __int_as_float(__builtin_amdgcn_mov_dpp(__float_as_int(ss), 0xB1, 0xf, 0xf, true)); ss += __int_as_float(__builtin_amdgcn_mov_dpp(__float_as_int(ss), 0x4E, 0xf, 0xf, true));
        ss += __int_as_float(__builtin_amdgcn_update_dpp(0, __float_as_int(ss), 0x124, 0xf, 0xf, false)); ss += __int_as_float(__builtin_amdgcn_update_dpp(0, __float_as_int(ss), 0x128, 0xf, 0xf, false));
        if (n == 0) __hip_atomic_store(S2u + (size_t)(tb + fq) * NSL + slice, __float_as_uint(ss), __ATOMIC_RELAXED, __HIP_MEMORY_SCOPE_AGENT);
        tp = tb;
    }
    if (tp >= 0) v_finalize4(a.out + (size_t)(tp + fq) * DM + 256 * slice + 4 * n, S2u, tp + fq, 0xFFFFFFFFu, xp, gf, lane);
}
__device__ __forceinline__ void p9_final(const Args& a, int lane, int gw, int NGW) {
    const float* S2 = (const float*)(a.ws + WS_SSP2); const bf16* X2 = (const bf16*)(a.ws + WS_XB1);
    f32x4 gfv[4];
#pragma unroll
    for (int j = 0; j < 4; ++j) gfv[j] = ((const f32x4*)a.in[I_GF])[4 * lane + j];
#pragma unroll 2
    for (int tok = gw; tok < T; tok += NGW) {
        const f32x4 p0 = *(const f32x4*)(S2 + (size_t)tok * NSL);
        const float r = rsqrtf(((p0[0] + p0[1]) + (p0[2] + p0[3])) * (1.f / DM) + EPS);
        const u32x4 xa = *(const u32x4*)(X2 + (size_t)tok * DM + 16 * lane), xb = *(const u32x4*)(X2 + (size_t)tok * DM + 16 * lane + 8);
        f32x4* orow = (f32x4*)(a.out + (size_t)tok * DM) + 4 * lane;
        orow[0] = (f32x4){bflo(xa[0]), bfhi(xa[0]), bflo(xa[1]), bfhi(xa[1])} * r * gfv[0];
        orow[1] = (f32x4){bflo(xa[2]), bfhi(xa[2]), bflo(xa[3]), bfhi(xa[3])} * r * gfv[1];
        orow[2] = (f32x4){bflo(xb[0]), bfhi(xb[0]), bflo(xb[1]), bfhi(xb[1])} * r * gfv[2];
        orow[3] = (f32x4){bflo(xb[2]), bfhi(xb[2]), bflo(xb[3]), bfhi(xb[3])} * r * gfv[3];
    }
}

__global__ void __launch_bounds__(NTHREADS, 2) mk_fwd(Args a) {
    extern __shared__ __attribute__((aligned(16))) unsigned char lds_raw[];
    LAS unsigned char* lds = (LAS unsigned char*)lds_raw;
    const int tid = threadIdx.x, lane = tid & 63, wave = __builtin_amdgcn_readfirstlane(tid >> 6), bid = blockIdx.x, G = gridDim.x;
    unsigned char* ws = a.ws; unsigned* ctl = (unsigned*)(ws + WS_CTL);
    volatile LAS unsigned* MISC = (volatile LAS unsigned*)(lds + LDSCTL_OFF);
    for (int u = tid; u < 64; u += NTHREADS) MISC[u] = 0u;
    __syncthreads();
    XcdBarrier bar; bar.bar = ctl + CW_BAR; bar.x = 0; bar.st = nullptr;
    if (N_LAUNCHES == 1) bar = xcd_barrier_post(ctl + CW_BAR, MISC + 8);
    const int lo = a.ph_lo, hi = a.ph_hi;
#ifndef REP_PHASE
#define REP_PHASE -1
#endif
#define IN(k) (lo <= (k) && (k) < hi)
#define REP(k) for (int rep_ = 0; rep_ < ((REP_PHASE) == (k) ? 2 : 1); ++rep_)
#define SEAM(k) do { if (IN(k) && IN((k) + 1)) xcd_barrier(bar); } while (0)
    const int gw = bid * NWAVES + wave, NGW = G * NWAVES;

    if (IN(0)) { REP(0) { p0_prologue(a, lds, tid, lane, wave, bid, G); __syncthreads(); } SEAM(0); }
    if (IN(1)) { REP(1) {
        p1_stats(a, lane, gw);
        pg8::Gemm g{(const bf16*)(ws + WS_XB), (const bf16*)(ws + WS_W1T), T, NZ, DM}; pg8::StaticOrder S; S.init(T, NZ, G, bid);
        EpiZ E{(bf16*)(ws + WS_Z), NZ, (const float*)(ws + WS_RS1), 8};
        pg8::gemm_phase<EpiZ, pg8::StaticOrder, true, true>(lds, g, S, E); }
        SEAM(1);
    }
    if (IN(2)) { REP(2)
        for (int task = bid; task < NBH * NCH + 512; task += G) {
            if (task < NBH * NCH) p2_dc_task(a, lds, tid, lane, wave, task); else p2_gmlp_task(a, lds, tid, lane, wave, task - NBH * NCH); }
        SEAM(2);
    }
    if (IN(3)) { REP(3) p3_scan(a, lds, tid, bid, G); SEAM(3); }
    if (IN(4)) { REP(4) for (int task = bid; task < NBH * NCH; task += G) p4_out_task(a, lds, tid, lane, wave, task); SEAM(4); }
    if (IN(5)) { REP(5) {
        pg8::Gemm g{(const bf16*)(ws + WS_Y), (const bf16*)(ws + WS_WOT), T, DM, DM}; pg8::StaticOrder S; S.init(T, DM, G, bid);
        EpiX1 E{a.in[I_X], (bf16*)(ws + WS_XB1), (float*)(ws + WS_SSP)};
        pg8::gemm_phase<EpiX1, pg8::StaticOrder, true, true>(lds, g, S, E);
        }
        SEAM(5);
    }
    if (IN(6)) { REP(6) {
        pg8::Gemm g{(const bf16*)(ws + WS_XB1), (const bf16*)(ws + WS_WQT), T, 2048, DM}; pg8::StaticOrder S; S.init(T, 2048, G, bid);
        EpiQ E{(bf16*)(ws + WS_Q), 2048, (const float*)(ws + WS_SSP)};
        pg8::gemm_phase<EpiQ, pg8::StaticOrder, true, true>(lds, g, S, E); }
        SEAM(6);
    }
    if (IN(7)) { REP(7) p7_topk(a, lds, tid, lane, wave, bid, G); SEAM(7); }
    if (IN(8)) { REP(8) p8a_u(a, lds, lane, wave, bid, G); SEAM(8); }
    if (IN(9)) { p8m_coef(a, tid, bid, G); SEAM(9); }
    if (IN(10)) { p8b_v(a, lds, lane, wave, bid, G); }
#undef IN
#undef SEAM
}

extern "C" void kernel_launch(void* const* d_in, const int* in_sizes, int n_in, void* d_out, int out_size, void* d_ws, size_t ws_size, hipStream_t stream) {
    static int grid = 0;
    if (grid == 0) {
        if (n_in != 19 || in_sizes[0] != T * DM || out_size != T * DM || ws_size < WS_END) { fprintf(stderr, "kernel_launch: unexpected shapes (n_in %d, in0 %d, out %d, ws %zu); nothing launched\n", n_in, n_in > 0 ? in_sizes[0] : -1, out_size, ws_size); grid = -1; return; }
        int dev = 0, cus = 0;
        if (hipGetDevice(&dev) != hipSuccess || hipDeviceGetAttribute(&cus, hipDeviceAttributeMultiprocessorCount, dev) != hipSuccess) { grid = -1; return; }
        if (hipFuncSetAttribute((const void*)mk_fwd, hipFuncAttributeMaxDynamicSharedMemorySize, LDS_BYTES) != hipSuccess) { fprintf(stderr, "kernel_launch: hipFuncSetAttribute failed\n"); grid = -1; return; }
        (void)hipGetLastError();
        grid = cus;
    }
    if (grid < 0) return;
    (void)hipMemsetAsync((char*)d_ws + WS_CTL, 0, CTL_ZERO_BYTES, stream);
    Args a{};
    for (int i = 0; i < 19; ++i) a.in[i] = (const float*)d_in[i];
    a.out = (float*)d_out; a.ws = (unsigned char*)d_ws;
    if (N_LAUNCHES == 1) { a.ph_lo = 0; a.ph_hi = NPHASE; hipLaunchKernelGGL(mk_fwd, dim3(grid), dim3(NTHREADS), LDS_BYTES, stream, a); }
    else for (int p = 0; p < NPHASE; ++p) { a.ph_lo = p; a.ph_hi = p + 1; hipLaunchKernelGGL(mk_fwd, dim3(grid), dim3(NTHREADS), LDS_BYTES, stream, a); }
}
```

```cpp
#include <hip/hip_runtime.h>
#include <cstdio>
#include <cstdint>

#ifndef MK_N_LAUNCHES
#define MK_N_LAUNCHES 1
#endif

#define LAS __attribute__((address_space(3)))
#define GAS __attribute__((address_space(1)))
typedef unsigned short bf16;
typedef short bf16x8 __attribute__((ext_vector_type(8)));
typedef float f32x4 __attribute__((ext_vector_type(4)));
typedef float f32x2 __attribute__((ext_vector_type(2)));
typedef _Float16 f16x2 __attribute__((ext_vector_type(2)));
typedef unsigned u32x4 __attribute__((ext_vector_type(4)));
typedef unsigned u32x2 __attribute__((ext_vector_type(2)));

namespace pg8 {
typedef unsigned short bf16_t;
constexpr int BM = 256, BK = 64, HALF = 128, HTB = HALF * BK * 2, STAGE_BYTES = 8 * HTB, NXCD = 8, WGM = 8;
__host__ __device__ __forceinline__ int lds_byte(int r, int c) { const int st = (r >> 4) * 2 + (c >> 5), rr = r & 15, cc = c & 31, ob = rr * 64 + cc * 2; return st * 1024 + (ob ^ (((ob >> 9) & 1) << 5)); }
__host__ __device__ __forceinline__ void stage_rc(int b, int& R, int& C) { const int st = b / 1024, sb = b % 1024, swz = sb ^ (((sb >> 9) & 1) << 5); R = (st >> 1) * 16 + swz / 64; C = (st & 1) * 32 + (swz % 64) / 2; }
__host__ __device__ __forceinline__ int perm32(int rho) { const int n = rho >> 4, i = rho & 15; return 8 * (i >> 2) + 4 * n + (i & 3); }
struct Unit { int pm, pn; };
struct Gemm { const bf16_t* A; const bf16_t* Bt; int M, N, K; };
struct StaticOrder {
    int nM, nN, nwg, G, c;
    __host__ __device__ void init(int M, int N, int G_, int c_) { nM = M / BM; nN = N / BM; nwg = nM * nN; G = G_; c = c_; }
    __host__ __device__ bool next(int i, Unit& u) const {
        const long L = (long)i * G + c; if (L >= nwg) return false;
        int wgid = (int)L; { const int q = nwg / NXCD, r = nwg % NXCD, xcd = wgid % NXCD, off = wgid / NXCD; wgid = (xcd < r ? xcd * (q + 1) : r * (q + 1) + (xcd - r) * q) + off; }
        const int nig = WGM * nN, gid = wgid / nig, fm = gid * WGM, gsz = (nM - fm) < WGM ? (nM - fm) : WGM;
        u.pm = fm + ((wgid % nig) % gsz); u.pn = (wgid % nig) / gsz; return true;
    }
    __device__ __forceinline__ void a_ready(const Unit&) const {}
    __device__ __forceinline__ void done(const Unit&) const {}
};
typedef __bf16 bf16x2_t __attribute__((ext_vector_type(2)));
__device__ __forceinline__ unsigned cvt_pk_bf16(float lo, float hi) { const f32x2 v = {lo, hi}; const bf16x2_t b = __builtin_convertvector(v, bf16x2_t); return __builtin_bit_cast(unsigned, b); }

template <class Epi, class Sched, bool ALIGN_EPI = false, bool SP2 = false>
__device__ __forceinline__ void gemm_phase(LAS unsigned char* lds, const Gemm g, const Sched& S, const Epi& E) {
    const int tid = threadIdx.x, wid = __builtin_amdgcn_readfirstlane(tid >> 6), lane = tid & 63, wr = wid >> 2, wc = wid & 3, fr = lane & 15, fq = lane >> 4;
    const int K = g.K, nt = K / BK;
    unsigned voffA[2], voffB[2];
#pragma unroll
    for (int i = 0; i < 2; ++i) { int R, C; stage_rc(tid * 16 + i * 8192, R, C); const int Rb = Epi::PERM ? ((R & ~31) + perm32(R & 31)) : R;
        voffA[i] = (unsigned)(R * K + C) * 2u; voffB[i] = (unsigned)(Rb * K + C) * 2u; }
    const size_t kstep = (size_t)(BK * 2);
    const size_t hstep = (size_t)HALF * K * 2;
    const size_t tstep = 2 * hstep;
    const unsigned ldsw = (unsigned)wid * 1024u;
    const int aoff = lds_byte(wr * 64 + fr, fq * 8), boff = lds_byte(wc * 32 + fr, fq * 8);
#define PG8_SA(b, h) (((b) * 2 + (h)) * HTB)
#define PG8_SB(b, h) ((4 + (b) * 2 + (h)) * HTB)
#define PG8_STAGE(bufoff, gbase, voff) do { _Pragma("unroll") for (int _i = 0; _i < 2; ++_i) \
        __builtin_amdgcn_global_load_lds((const unsigned*)((const char*)(gbase) + (voff)[_i]), (LAS unsigned*)(lds + (bufoff) + ldsw + _i * 8192), 16, 0, 0); } while (0)
#define PG8_LDA(dst, b, h) do { _Pragma("unroll") for (int m = 0; m < 4; ++m) _Pragma("unroll") for (int k = 0; k < 2; ++k) dst[m][k] = *(const LAS bf16x8*)(lds + PG8_SA(b, h) + aoff + m * 2048 + k * 1024); } while (0)
#define PG8_LDB(dst, b, h) do { _Pragma("unroll") for (int n = 0; n < 2; ++n) _Pragma("unroll") for (int k = 0; k < 2; ++k) dst[n][k] = *(const LAS bf16x8*)(lds + PG8_SB(b, h) + boff + n * 2048 + k * 1024); } while (0)
#define PG8_MMA(ai, bj, At, Bt) do { __builtin_amdgcn_s_setprio(1); _Pragma("unroll") for (int m = 0; m < 4; ++m) _Pragma("unroll") for (int n = 0; n < 2; ++n) _Pragma("unroll") for (int k = 0; k < 2; ++k) \
        acc[ai][bj][m][n] = __builtin_amdgcn_mfma_f32_16x16x32_bf16(Bt[n][k], At[m][k], acc[ai][bj][m][n], 0, 0, 0); __builtin_amdgcn_s_setprio(0); } while (0)
#define PG8_WAIT_V(n) asm volatile("s_waitcnt vmcnt(" #n ")" ::: "memory")
#define PG8_WAIT_L(n) asm volatile("s_waitcnt lgkmcnt(" #n ")" ::: "memory")
#define PG8_BAR __builtin_amdgcn_s_barrier()
#define PG8_SCHED __builtin_amdgcn_sched_barrier(0)
    Unit cur, nxt; int ui = 0;
    if (!S.next(0, cur)) return;
    f32x4 acc[2][2][4][2];
#pragma unroll
    for (int a = 0; a < 2; ++a)
#pragma unroll
        for (int b = 0; b < 2; ++b)
#pragma unroll
            for (int m = 0; m < 4; ++m)
#pragma unroll
                for (int n = 0; n < 2; ++n) acc[a][b][m][n] = (f32x4){0.f, 0.f, 0.f, 0.f};
    bf16x8 At[4][2], B0[2][2], B1[2][2];
    const char* cA = (const char*)g.A + (size_t)cur.pm * tstep; const char* cB = (const char*)g.Bt + (size_t)cur.pn * tstep;
    S.a_ready(cur);
    if constexpr (SP2) {
        PG8_STAGE(PG8_SB(0, 0), cB, voffB); PG8_STAGE(PG8_SB(0, 1), cB + hstep, voffB); PG8_STAGE(PG8_SA(0, 0), cA, voffA); PG8_STAGE(PG8_SA(0, 1), cA + hstep, voffA);
        if (wr == 1) PG8_BAR;
        PG8_WAIT_V(2); PG8_BAR;
        PG8_STAGE(PG8_SB(1, 0), cB + kstep, voffB); PG8_STAGE(PG8_SA(1, 0), cA + kstep, voffA); PG8_STAGE(PG8_SB(1, 1), cB + hstep + kstep, voffB);
        PG8_WAIT_V(6); PG8_BAR;
    } else {
        PG8_STAGE(PG8_SB(0, 0), cB, voffB); PG8_STAGE(PG8_SA(0, 0), cA, voffA); PG8_STAGE(PG8_SB(0, 1), cB + hstep, voffB); PG8_STAGE(PG8_SA(0, 1), cA + hstep, voffA);
        if (wr == 1) PG8_BAR;
        PG8_WAIT_V(4); PG8_BAR;
        PG8_STAGE(PG8_SB(1, 0), cB + kstep, voffB); PG8_STAGE(PG8_SA(1, 0), cA + kstep, voffA); PG8_STAGE(PG8_SB(1, 1), cB + hstep + kstep, voffB);
        PG8_WAIT_V(6); PG8_BAR;
    }
    for (;;) {
        const bool has_next = S.next(ui + 1, nxt);
        const char* nA = has_next ? (const char*)g.A + (size_t)nxt.pm * tstep : cA; const char* nB = has_next ? (const char*)g.Bt + (size_t)nxt.pn * tstep : cB;
        for (int t = 0; t < nt; t += 2) {
            const bool last = (t == nt - 2);
            const char* a1 = cA + (size_t)(t + 1) * kstep;
            const char* a2 = last ? nA : cA + (size_t)(t + 2) * kstep; const char* b2 = last ? nB : cB + (size_t)(t + 2) * kstep;
            const char* a3 = a2 + kstep; const char* b3 = b2 + kstep;
            if (last && has_next) S.a_ready(nxt);
            if constexpr (SP2) {
            PG8_LDB(B0, 0, 0); PG8_LDB(B1, 0, 1); PG8_SCHED; PG8_LDA(At, 0, 0); PG8_STAGE(PG8_SA(1, 1), a1 + hstep, voffA);
            PG8_WAIT_V(8); PG8_WAIT_L(0); PG8_BAR; PG8_MMA(0, 0, At, B0); PG8_MMA(0, 1, At, B1); PG8_BAR; PG8_SCHED;
            PG8_LDA(At, 0, 1); PG8_STAGE(PG8_SB(0, 0), b2, voffB); PG8_STAGE(PG8_SB(0, 1), b2 + hstep, voffB); PG8_STAGE(PG8_SA(0, 0), a2, voffA);
            PG8_WAIT_V(8); PG8_WAIT_L(0); PG8_BAR; PG8_MMA(1, 0, At, B0); PG8_MMA(1, 1, At, B1); PG8_BAR; PG8_SCHED;
            PG8_LDB(B0, 1, 0); PG8_LDB(B1, 1, 1); PG8_SCHED; PG8_LDA(At, 1, 0); PG8_STAGE(PG8_SA(0, 1), a2 + hstep, voffA);
            PG8_WAIT_V(8); PG8_WAIT_L(0); PG8_BAR; PG8_MMA(0, 0, At, B0); PG8_MMA(0, 1, At, B1); PG8_BAR; PG8_SCHED;
            PG8_LDA(At, 1, 1); PG8_STAGE(PG8_SB(1, 0), b3, voffB); PG8_STAGE(PG8_SB(1, 1), b3 + hstep, voffB); PG8_STAGE(PG8_SA(1, 0), a3, voffA);
            PG8_WAIT_V(8); PG8_WAIT_L(0); PG8_BAR; PG8_MMA(1, 0, At, B0); PG8_MMA(1, 1, At, B1); PG8_BAR; PG8_SCHED;
            } else {
            PG8_LDB(B0, 0, 0); PG8_SCHED; PG8_LDA(At, 0, 0); PG8_STAGE(PG8_SA(1, 1), a1 + hstep, voffA);
            PG8_WAIT_L(8); PG8_BAR; PG8_WAIT_L(0); PG8_MMA(0, 0, At, B0); PG8_BAR; PG8_SCHED;
            PG8_LDB(B1, 0, 1); PG8_STAGE(PG8_SB(0, 0), b2, voffB);
            PG8_BAR; PG8_WAIT_L(0); PG8_MMA(0, 1, At, B1); PG8_BAR;
            PG8_LDA(At, 0, 1); PG8_STAGE(PG8_SA(0, 0), a2, voffA);
            PG8_BAR; PG8_WAIT_L(0); PG8_MMA(1, 0, At, B0); PG8_BAR; PG8_SCHED;
            PG8_STAGE(PG8_SB(0, 1), b2 + hstep, voffB);
            PG8_WAIT_V(6); PG8_BAR; PG8_MMA(1, 1, At, B1); PG8_BAR;
            PG8_LDB(B0, 1, 0); PG8_SCHED; PG8_LDA(At, 1, 0); PG8_STAGE(PG8_SA(0, 1), a2 + hstep, voffA);
            PG8_WAIT_L(8); PG8_BAR; PG8_WAIT_L(0); PG8_MMA(0, 0, At, B0); PG8_BAR; PG8_SCHED;
            PG8_LDB(B1, 1, 1); PG8_STAGE(PG8_SB(1, 0), b3, voffB);
            PG8_BAR; PG8_WAIT_L(0); PG8_MMA(0, 1, At, B1); PG8_BAR;
            PG8_LDA(At, 1, 1); PG8_STAGE(PG8_SA(1, 0), a3, voffA);
            PG8_BAR; PG8_WAIT_L(0); PG8_MMA(1, 0, At, B0); PG8_BAR; PG8_SCHED;
            PG8_STAGE(PG8_SB(1, 1), b3 + hstep, voffB);
            PG8_WAIT_V(6); PG8_BAR; PG8_MMA(1, 1, At, B1); PG8_BAR;
            }
        }
        if constexpr (ALIGN_EPI) { if (wr == 0) PG8_BAR; }
        E(acc, cur, wr, wc, fr, fq);
        if (!has_next) break;
#pragma unroll
        for (int a = 0; a < 2; ++a)
#pragma unroll
            for (int b = 0; b < 2; ++b)
#pragma unroll
                for (int m = 0; m < 4; ++m)
#pragma unroll
                    for (int n = 0; n < 2; ++n) acc[a][b][m][n] = (f32x4){0.f, 0.f, 0.f, 0.f};
        cur = nxt; cA = nA; cB = nB; ++ui;
        if constexpr (ALIGN_EPI) { if (wr == 1) PG8_BAR; }
    }
    PG8_WAIT_V(0);
    if constexpr (!ALIGN_EPI) { if (wr == 0) PG8_BAR; }
    PG8_BAR;
#undef PG8_SA
#undef PG8_SB
#undef PG8_STAGE
#undef PG8_LDA
#undef PG8_LDB
#undef PG8_MMA
#undef PG8_WAIT_V
#undef PG8_WAIT_L
#undef PG8_BAR
#undef PG8_SCHED
}
}

constexpr int NWAVES = 8, NTHREADS = 512;
constexpr int BATCH = 4, SEQ = 4096, DM = 1024, T = BATCH * SEQ;
constexpr int NH = 4, DH = 128, MW = 512, NIN = 3080, NZ = 3072, NBH = BATCH * NH, NCH = SEQ / 64;
constexpr int PH = 8, PKEYS = 128, PQD = 256, TOPK = 16, NEXP = 16384;
constexpr float EPS = 1e-6f;
constexpr int NPHASE = 11;
constexpr int N_LAUNCHES = MK_N_LAUNCHES;

constexpr size_t MiB = 1u << 20;
constexpr size_t WS_CTL = 0, CTL_ZERO_BYTES = 65536;
constexpr size_t WS_SUMSQ2 = 128 * 1024;
constexpr size_t WS_RS1 = 1 * MiB;
constexpr size_t WS_LF = WS_RS1 + (size_t)T * 4;
constexpr size_t WS_IG = WS_LF + (size_t)NBH * SEQ * 4;
constexpr size_t WS_BC = WS_IG + (size_t)NBH * SEQ * 4;
constexpr size_t WS_AV = WS_BC + (size_t)NBH * SEQ * 4;
constexpr size_t WS_BL = WS_AV + (size_t)NBH * SEQ * 4;
constexpr size_t WS_AM = WS_BL + (size_t)NBH * NCH * 4;
constexpr size_t WS_DN = WS_AM + (size_t)NBH * NCH * 4;
constexpr size_t WS_NP = WS_DN + (size_t)NBH * NCH * DH * 4;
constexpr size_t WS_SU = WS_NP + (size_t)NBH * NCH * DH * 4;
constexpr size_t WS_SV = WS_SU + (size_t)NEXP * 4;
constexpr size_t WS_SMALL_END = WS_SV + (size_t)NEXP * 4;
constexpr size_t WS_W1T = 4 * MiB, WS_WOT = 10 * MiB, WS_WQT = 12 * MiB, WS_SKB = 16 * MiB;
constexpr size_t WS_XB = 17 * MiB, WS_Y = WS_XB;
constexpr size_t WS_XB1 = 49 * MiB;
constexpr size_t WS_Z = 81 * MiB;
constexpr size_t WS_Q = WS_Z, WS_IDX = WS_Z + 64 * MiB, WS_GATE = WS_Z + 72 * MiB;
constexpr size_t WS_DC = 177 * MiB, WS_UB = WS_DC;
constexpr size_t WS_CP = 209 * MiB, WS_VB = WS_CP;
constexpr size_t WS_SSP = 241 * MiB;
constexpr size_t WS_SSP2 = 242 * MiB;
constexpr size_t WS_COEF = WS_Z + 80 * MiB, WS_COEF_OS = WS_COEF + 7 * MiB;
constexpr size_t WS_IDXV = WS_XB;
constexpr size_t WS_APART = WS_Q;
constexpr size_t WS_END = 243 * MiB;
static_assert(WS_SMALL_END <= WS_W1T && WS_SKB + 512 * 1024 <= WS_XB, "ws map");
constexpr int CW_TMO = 0, CW_CODE = 1, CW_BAR = 4096;

constexpr int LDS_BYTES = 147456, LDSCTL_OFF = LDS_BYTES - 256;

typedef GAS unsigned gu32;
#define RLX_AGENT __ATOMIC_RELAXED, __HIP_MEMORY_SCOPE_AGENT
#define LDS_WAIT() asm volatile("s_waitcnt lgkmcnt(0)" ::: "memory")
__device__ __forceinline__ unsigned pk2(float lo, float hi) { return pg8::cvt_pk_bf16(lo, hi); }
__device__ __forceinline__ float bf2f(unsigned short b) { return __uint_as_float((unsigned)b << 16); }
__device__ __forceinline__ float bflo(unsigned w) { return __uint_as_float(w << 16); }
__device__ __forceinline__ float bfhi(unsigned w) { return __uint_as_float(w & 0xffff0000u); }
__device__ __forceinline__ float wave_sum(float v) {
#pragma unroll
    for (int o = 1; o < 64; o <<= 1) v += __shfl_xor(v, o);
    return v;
}
__device__ __forceinline__ float wave_max(float v) {
#pragma unroll
    for (int o = 1; o < 64; o <<= 1) v = fmaxf(v, __shfl_xor(v, o));
    return v;
}
__device__ __forceinline__ float sigmoidf_(float x) { return __builtin_amdgcn_rcpf(1.f + __expf(-x)); }
__device__ __forceinline__ float siluf_(float x) { return x * sigmoidf_(x); }
__device__ __forceinline__ float gelu_tanh(float x) { const float u = 1.5957691216057308f * (x + 0.044715f * x * x * x); return x * sigmoidf_(u); }

#define XB_TMO      128
#define XB_XCNT(j)  (256  + 64 * (j))
#define XB_XSUB(j)  (1280 + 64 * (j))
#define XB_XGEN(j)  (2304 + 64 * (j))
#define XB_TOP      3328
#define XB_TOPGEN   3392
#define XCD_BAR_WORDS 3456
#define XB_SPIN_CAP (1u << 18)
__device__ __forceinline__ unsigned xb_ld(unsigned* p)              { return __hip_atomic_load(p, __ATOMIC_RELAXED, __HIP_MEMORY_SCOPE_AGENT); }
__device__ __forceinline__ unsigned xb_add(unsigned* p, unsigned v) { return __hip_atomic_fetch_add(p, v, __ATOMIC_RELAXED, __HIP_MEMORY_SCOPE_AGENT); }
__device__ __forceinline__ unsigned xb_xcc_id() { return (unsigned)__builtin_amdgcn_s_getreg((3 << 11) | 20) & 0xFu; }
#define XB_SPIN(cond, bar) do { unsigned _sp = 0; while (cond) { __builtin_amdgcn_s_sleep(1); \
    if ((++_sp & 255u) == 0u) { if (xb_ld(&(bar)[XB_TMO])) break; if (_sp > XB_SPIN_CAP) { atomicAdd(&(bar)[XB_TMO], 1u); break; } } } } while (0)
struct XcdBarrier { unsigned* bar; unsigned x; volatile LAS unsigned* st; };
__device__ __forceinline__ XcdBarrier xcd_barrier_post(unsigned* bar, volatile LAS unsigned* st) {
    XcdBarrier b; b.bar = bar; b.x = xb_xcc_id(); b.st = st;
    if (threadIdx.x == 0) (void)xb_add(&bar[XB_XCNT(b.x)], 1u);
    return b;
}
__device__ __forceinline__ void xcd_barrier_complete(unsigned* bar, unsigned x, unsigned& nloc, unsigned& nx) {
    const unsigned G = gridDim.x * gridDim.y * gridDim.z;
    unsigned sum, cnt, mine, sp = 0u;
    for (;;) {
        sum = 0u; cnt = 0u; mine = 0u;
#pragma unroll
        for (unsigned j = 0; j < 16; ++j) { const unsigned c = xb_ld(&bar[XB_XCNT(j)]); sum += c; cnt += (c > 0u) ? 1u : 0u; mine = (j == x) ? c : mine; }
        if (sum == G) break;
        __builtin_amdgcn_s_sleep(1);
        if ((++sp & 255u) == 0u) { if (xb_ld(&bar[XB_TMO])) break; if (sp > XB_SPIN_CAP) { atomicAdd(&bar[XB_TMO], 1u); break; } }
    }
    nloc = mine > 0u ? mine : 1u; nx = cnt > 0u ? cnt : 1u;
}
__device__ __forceinline__ void xcd_barrier(const XcdBarrier& b) {
    asm volatile("s_waitcnt vmcnt(0)" ::: "memory");
    __syncthreads();
    if (threadIdx.x == 0) {
        unsigned* bar = b.bar;
        __builtin_amdgcn_s_waitcnt(0);
        unsigned nloc = b.st[0], nx = b.st[1];
        if (nloc == 0u) { xcd_barrier_complete(bar, b.x, nloc, nx); b.st[0] = nloc; b.st[1] = nx; }
        const unsigned old = xb_add(&bar[XB_XSUB(b.x)], 1u);
        const unsigned gen = old / nloc;
        if (old + 1u == (gen + 1u) * nloc) {
            __builtin_amdgcn_fence(__ATOMIC_RELEASE, "agent");
            asm volatile("s_waitcnt vmcnt(0)" ::: "memory");
            const unsigned og = xb_add(&bar[XB_TOP], 1u);
            const unsigned tg = og / nx;
            if (og + 1u == (tg + 1u) * nx) xb_add(&bar[XB_TOPGEN], 1u);
            else XB_SPIN(xb_ld(&bar[XB_TOPGEN]) == tg, bar);
            __builtin_amdgcn_fence(__ATOMIC_ACQUIRE, "agent");
            xb_add(&bar[XB_XGEN(b.x)], 1u);
            asm volatile("s_waitcnt vmcnt(0)" ::: "memory");
        } else {
            XB_SPIN(xb_ld(&bar[XB_XGEN(b.x)]) == gen, bar);
            __builtin_amdgcn_fence(__ATOMIC_ACQUIRE, "agent");
            asm volatile("s_waitcnt vmcnt(0)" ::: "memory");
        }
    }
    __syncthreads();
}

__device__ __forceinline__ bf16x8 ldfrag(const LAS bf16* img, int ld, int i0, int k0, int lane) {
    return *(const LAS bf16x8*)(img + (i0 + (lane & 15)) * ld + k0 + 8 * (lane >> 4));
}
typedef short s16x4 __attribute__((ext_vector_type(4)));
__device__ __forceinline__ bf16x8 ldfragT(const LAS bf16* img, int ld, int i0, int k0, int lane) {
    const LAS bf16* p = img + (k0 + 8 * (lane >> 4) + ((lane & 15) >> 2)) * ld + i0 + 4 * (lane & 3);
    const s16x4 a = __builtin_amdgcn_ds_read_tr16_b64_v4i16((LAS s16x4*)p), b = __builtin_amdgcn_ds_read_tr16_b64_v4i16((LAS s16x4*)(p + 4 * ld));
    return (bf16x8){a[0], a[1], a[2], a[3], b[0], b[1], b[2], b[3]};
}
#define MMA16(nf, mf, acc) __builtin_amdgcn_mfma_f32_16x16x32_bf16(nf, mf, acc, 0, 0, 0)

__device__ __forceinline__ float row_rs2(const float* ssp, int r) {
    const f32x4* p = (const f32x4*)(ssp + (size_t)r * 16); const f32x4 a = p[0], b = p[1], c = p[2], d = p[3];
    const float s = (((a[0] + a[1]) + (a[2] + a[3])) + ((b[0] + b[1]) + (b[2] + b[3]))) + (((c[0] + c[1]) + (c[2] + c[3])) + ((d[0] + d[1]) + (d[2] + d[3])));
    return rsqrtf(s * (1.f / 1024.f) + 1e-6f);
}
template <int S2, int S1, int S0>
__device__ __forceinline__ void bfly16(float (&v)[16], int rank) {
    { const bool b = (rank >> 2) & 1;
#pragma unroll
      for (int j = 0; j < 8; ++j) { const float keep = b ? v[8 + j] : v[j], send = b ? v[j] : v[8 + j]; v[j] = keep + __shfl_xor(send, S2); } }
    { const bool b = (rank >> 1) & 1;
#pragma unroll
      for (int j = 0; j < 4; ++j) { const float keep = b ? v[4 + j] : v[j], send = b ? v[j] : v[4 + j]; v[j] = keep + __shfl_xor(send, S1); } }
    { const bool b = rank & 1;
#pragma unroll
      for (int j = 0; j < 2; ++j) { const float keep = b ? v[2 + j] : v[j], send = b ? v[j] : v[2 + j]; v[j] = keep + __shfl_xor(send, S0); } }
}
template <int S2, int S1, int S0>
__device__ __forceinline__ void bfly16i(int (&v)[16], int rank) {
    { const bool b = (rank >> 2) & 1;
#pragma unroll
      for (int j = 0; j < 8; ++j) { const int keep = b ? v[8 + j] : v[j], send = b ? v[j] : v[8 + j]; v[j] = keep + __shfl_xor(send, S2); } }
    { const bool b = (rank >> 1) & 1;
#pragma unroll
      for (int j = 0; j < 4; ++j) { const int keep = b ? v[4 + j] : v[j], send = b ? v[j] : v[4 + j]; v[j] = keep + __shfl_xor(send, S1); } }
    { const bool b = rank & 1;
#pragma unroll
      for (int j = 0; j < 2; ++j) { const int keep = b ? v[2 + j] : v[j], send = b ? v[j] : v[2 + j]; v[j] = keep + __shfl_xor(send, S0); } }
}
typedef pg8::Unit Unit;
struct EpiZ {
    static constexpr bool PERM = true;
    bf16* O; int ldc; const float* rs; int act_pn;
    __device__ __forceinline__ void operator()(const f32x4 (&acc)[2][2][4][2], const Unit& u, int wr, int wc, int fr, int fq) const {
        const int row0 = u.pm * 256 + wr * 64 + fr, col0 = u.pn * 256 + wc * 32 + 8 * fq; const bool act = u.pn >= act_pn;
#pragma unroll
        for (int ai = 0; ai < 2; ++ai)
#pragma unroll
            for (int m = 0; m < 4; ++m) { const int r = row0 + ai * 128 + m * 16; const float s = rs[r]; bf16* rowp = O + (size_t)r * ldc + col0;
#pragma unroll
                for (int bj = 0; bj < 2; ++bj) { f32x4 v0 = acc[ai][bj][m][0] * s, v1 = acc[ai][bj][m][1] * s;
                    if (act) {
#pragma unroll
                        for (int e = 0; e < 4; ++e) { v0[e] = gelu_tanh(v0[e]); v1[e] = gelu_tanh(v1[e]); } }
                    u32x4 w; w.x = pk2(v0[0], v0[1]); w.y = pk2(v0[2], v0[3]); w.z = pk2(v1[0], v1[1]); w.w = pk2(v1[2], v1[3]);
                    *(u32x4*)(rowp + bj * 128) = w; } }
    }
};
struct EpiQ {
    static constexpr bool PERM = true;
    bf16* O; int ldc; const float* sumsq;
    __device__ __forceinline__ void operator()(const f32x4 (&acc)[2][2][4][2], const Unit& u, int wr, int wc, int fr, int fq) const {
        const int row0 = u.pm * 256 + wr * 64 + fr, col0 = u.pn * 256 + wc * 32 + 8 * fq;
#pragma unroll
        for (int ai = 0; ai < 2; ++ai)
#pragma unroll
            for (int m = 0; m < 4; ++m) { const int r = row0 + ai * 128 + m * 16; const float s = row_rs2(sumsq, r); bf16* rowp = O + (size_t)r * ldc + col0;
#pragma unroll
                for (int bj = 0; bj < 2; ++bj) { const f32x4 v0 = acc[ai][bj][m][0] * s, v1 = acc[ai][bj][m][1] * s;
                    u32x4 w; w.x = pk2(v0[0], v0[1]); w.y = pk2(v0[2], v0[3]); w.z = pk2(v1[0], v1[1]); w.w = pk2(v1[2], v1[3]);
                    *(u32x4*)(rowp + bj * 128) = w; } }
    }
};
struct EpiX1 {
    static constexpr bool PERM = true;
    const float* X; bf16* XB1; float* sumsq;
    __device__ __forceinline__ void operator()(const f32x4 (&acc)[2][2][4][2], const Unit& u, int wr, int wc, int fr, int fq) const {
        const int row0 = u.pm * 256 + wr * 64 + fr, col0 = u.pn * 256 + wc * 32 + 8 * fq;
#pragma unroll
        for (int ai = 0; ai < 2; ++ai)
#pragma unroll
            for (int m = 0; m < 4; ++m) { const int r = row0 + ai * 128 + m * 16; float ss = 0.f;
#pragma unroll
                for (int bj = 0; bj < 2; ++bj) { const size_t off = (size_t)r * DM + col0 + bj * 128;
                    const f32x4 xa = *(const f32x4*)(X + off), xb = *(const f32x4*)(X + off + 4);
                    const f32x4 v0 = acc[ai][bj][m][0] + xa, v1 = acc[ai][bj][m][1] + xb;
                    u32x4 w; w.x = pk2(v0[0], v0[1]); w.y = pk2(v0[2], v0[3]); w.z = pk2(v1[0], v1[1]); w.w = pk2(v1[2], v1[3]);
                    *(u32x4*)(XB1 + off) = w;
                    ss += (v0[0] * v0[0] + v0[1] * v0[1]) + (v0[2] * v0[2] + v0[3] * v0[3]) + (v1[0] * v1[0] + v1[1] * v1[1]) + (v1[2] * v1[2] + v1[3] * v1[3]); }
                ss += __shfl_xor(ss, 16); ss += __shfl_xor(ss, 32);
                if (fq == 0) sumsq[(size_t)r * 16 + u.pn * 4 + wc] = ss; }
    }
};

struct Args { const float* in[19]; float* out; unsigned char* ws; int ph_lo, ph_hi; };
enum { I_X = 0, I_G1, I_WIN, I_CW, I_CB, I_BI, I_BF, I_MNG, I_LNG, I_LNB, I_WS, I_BS, I_WOUT, I_G2, I_WQ, I_SK, I_PU, I_PV, I_GF };

__device__ __forceinline__ void transpose_item(const float* W, int ldsrc, int K, bf16* WT, const float* gk, LAS float* scr, int k0, int n0src, int n0dst, int lane) {
    float wv[32];
#pragma unroll
    for (int i = 0; i < 32; ++i) { const int kk = 2 * i + (lane >> 5); wv[i] = W[(size_t)(k0 + kk) * ldsrc + n0src + (lane & 31)]; }
    if (gk) {
#pragma unroll
        for (int i = 0; i < 32; ++i) wv[i] *= gk[k0 + 2 * i + (lane >> 5)]; }
#pragma unroll
    for (int i = 0; i < 32; ++i) { const int kk = 2 * i + (lane >> 5); scr[kk * 33 + (lane & 31)] = wv[i]; }
    LDS_WAIT(); asm volatile("" ::: "memory");
    const int c = lane & 7;
#pragma unroll
    for (int j = 0; j < 4; ++j) { const int n = (lane >> 3) + 8 * j; const LAS float* s = scr + (8 * c) * 33 + n;
        u32x4 o; o.x = pk2(s[0 * 33], s[1 * 33]); o.y = pk2(s[2 * 33], s[3 * 33]); o.z = pk2(s[4 * 33], s[5 * 33]); o.w = pk2(s[6 * 33], s[7 * 33]);
        *(u32x4*)(WT + (size_t)(n0dst + n) * K + k0 + 8 * c) = o; }
    LDS_WAIT(); asm volatile("" ::: "memory");
}
__device__ __forceinline__ float logsigmoidf_(float x) { return fminf(x, 0.f) - log1pf(__expf(-fabsf(x))); }

__device__ __forceinline__ void p0_prologue(const Args& a, LAS unsigned char* lds, int tid, int lane, int wave, int bid, int G) {
    unsigned char* ws = a.ws;
    const float* win = a.in[I_WIN]; const float* g1 = a.in[I_G1];
    LAS bf16* WGB = (LAS bf16*)lds;
    { float wv[16], gv[16];
#pragma unroll
      for (int i = 0; i < 16; ++i) { const int idx = tid + NTHREADS * i, k = idx >> 3, c = idx & 7; wv[i] = win[(size_t)k * NIN + 2048 + c]; gv[i] = g1[k]; }
#pragma unroll
      for (int i = 0; i < 16; ++i) { const int idx = tid + NTHREADS * i, k = idx >> 3, c = idx & 7; WGB[c * 1032 + k] = (bf16)(pk2(wv[i] * gv[i], 0.f) & 0xffffu); }
      for (int i = tid; i < 8 * 1032 / 2; i += NTHREADS) ((LAS unsigned*)(WGB + 8 * 1032))[i] = 0u; }
    __syncthreads();
    const int gw = bid * NWAVES + wave, NGW = G * NWAVES;
    if (wave >= 4) {
        LAS float* scr = (LAS float*)(lds + 40960 + (wave - 4) * 8448);
        const int tw = bid * 4 + (wave - 4), NTW = G * 4;
        constexpr int I1 = 16 * 96, I2 = 16 * 32, I3 = 16 * 64;
        for (int it = tw; it < I1 + I2 + I3; it += NTW) {
            int r = it;
            if (r < I1) { const int kb = r / 96, nb = r % 96, n0 = 32 * nb; transpose_item(win, NIN, DM, (bf16*)(ws + WS_W1T), g1, scr, 64 * kb, n0 + (n0 >= 2048 ? 8 : 0), n0, lane); continue; } r -= I1;
            if (r < I2) { const int kb = r / 32, nb = r % 32; transpose_item(a.in[I_WOUT], DM, DM, (bf16*)(ws + WS_WOT), nullptr, scr, 64 * kb, 32 * nb, 32 * nb, lane); continue; } r -= I2;
            { const int kb = r / 64, nb = r % 64; transpose_item(a.in[I_WQ], 2048, DM, (bf16*)(ws + WS_WQT), a.in[I_G2], scr, 64 * kb, 32 * nb, 32 * nb, lane); }
        }
        { const f32x4* src = (const f32x4*)a.in[I_SK]; u32x2* dst = (u32x2*)(ws + WS_SKB);
          for (int i = tw * 64 + lane; i < PH * 2 * PKEYS * 128 / 4; i += NTW * 64) { const f32x4 v = src[i]; u32x2 o; o.x = pk2(v[0], v[1]); o.y = pk2(v[2], v[3]); dst[i] = o; } }
    } else {
        const float* x = a.in[I_X]; bf16* XB = (bf16*)(ws + WS_XB); float* rs1 = (float*)(ws + WS_RS1); float* LF = (float*)(ws + WS_LF); float* IG = (float*)(ws + WS_IG);
        const int fr = lane & 15, fq = lane >> 4;
        f32x4 bias = (f32x4){0.f, 0.f, 0.f, 0.f};
        if (fq == 0) bias = *(const f32x4*)a.in[I_BI]; else if (fq == 1) bias = *(const f32x4*)a.in[I_BF];
        for (int task = bid * 4 + wave; task < T / 16; task += G * 4) {
            const int m = 16 * task + fr; const float* xr = x + (size_t)m * DM + 8 * fq; bf16* xo = XB + (size_t)m * DM + 8 * fq;
            f32x4 acc = (f32x4){0.f, 0.f, 0.f, 0.f}; float ss = 0.f;
#pragma unroll 8
            for (int kk = 0; kk < 32; ++kk) {
                const f32x4 a0 = *(const f32x4*)(xr + 32 * kk), a1 = *(const f32x4*)(xr + 32 * kk + 4);
                ss += ((a0[0] * a0[0] + a0[1] * a0[1]) + (a0[2] * a0[2] + a0[3] * a0[3])) + ((a1[0] * a1[0] + a1[1] * a1[1]) + (a1[2] * a1[2] + a1[3] * a1[3]));
                u32x4 w; w.x = pk2(a0[0], a0[1]); w.y = pk2(a0[2], a0[3]); w.z = pk2(a1[0], a1[1]); w.w = pk2(a1[2], a1[3]);
                *(u32x4*)(xo + 32 * kk) = w;
                acc = MMA16(ldfrag(WGB, 1032, 0, 32 * kk, lane), __builtin_bit_cast(bf16x8, w), acc);
            }
            ss += __shfl_xor(ss, 16); ss += __shfl_xor(ss, 32);
            const float rs = rsqrtf(ss * (1.f / DM) + EPS);
            const int b = m >> 12, sq = m & (SEQ - 1);
            if (fq == 0) { rs1[m] = rs;
#pragma unroll
                for (int i = 0; i < 4; ++i) IG[(size_t)(b * NH + i) * SEQ + sq] = acc[i] * rs + bias[i]; }
            else if (fq == 1) {
#pragma unroll
                for (int i = 0; i < 4; ++i) LF[(size_t)(b * NH + i) * SEQ + sq] = logsigmoidf_(acc[i] * rs + bias[i]); }
        }
    }
}

__device__ __forceinline__ void p1_stats(const Args& a, int lane, int gw) {
    if (gw >= NBH * NCH) return;
    unsigned char* ws = a.ws; const int bh = gw >> 6, c = gw & 63; const size_t o = (size_t)bh * SEQ + c * 64 + lane;
    float b = ((const float*)(ws + WS_LF))[o];
#pragma unroll
    for (int d = 1; d < 64; d <<= 1) { const float t = __shfl_up(b, d); if (lane >= d) b += t; }
    const float av = ((const float*)(ws + WS_IG))[o] - b;
    ((float*)(ws + WS_BC))[o] = b; ((float*)(ws + WS_AV))[o] = av;
    const float bL = __shfl(b, 63), am = wave_max(av);
    if (lane == 0) { ((float*)(ws + WS_BL))[gw] = bL; ((float*)(ws + WS_AM))[gw] = am; }
}
__device__ __forceinline__ float m_scan_excl(const float* bL, const float* am, int bh, int lane) {
    float A = bL[bh * 64 + lane], B = am[bh * 64 + lane] + A;
#pragma unroll
    for (int d = 1; d < 64; d <<= 1) { const float Ap = __shfl_up(A, d), Bp = __shfl_up(B, d); if (lane >= d) { B = fmaxf(Bp + A, B); A = Ap + A; } }
    const float m = fmaxf(A, B);
    const float mp = __shfl_up(m, 1); return lane == 0 ? 0.f : mp;
}
__device__ __forceinline__ float m_prev_of(const float* bL, const float* am, int bh, int c) {
    return __shfl(m_scan_excl(bL, am, bh, (int)(threadIdx.x & 63)), c);
}

struct ConvIn { u32x4 x[5]; f32x4 w[8]; f32x4 b[2]; };
__device__ __forceinline__ void conv_load(ConvIn& C, const bf16* Z, const float* cw, const float* cb, int tok0, int sloc0, int r0, int ch0) {
#pragma unroll
    for (int j = 0; j < 4; ++j) { C.w[2 * j] = *(const f32x4*)(cw + j * 1024 + ch0); C.w[2 * j + 1] = *(const f32x4*)(cw + j * 1024 + ch0 + 4); }
    C.b[0] = *(const f32x4*)(cb + ch0); C.b[1] = *(const f32x4*)(cb + ch0 + 4);
#pragma unroll
    for (int i = 0; i < 5; ++i) { const int sr = r0 - 3 + i; const bool ok = sloc0 + sr >= 0; const u32x4 q = *(const u32x4*)(Z + (size_t)(tok0 + (ok ? sr : 0)) * NZ + ch0);
        C.x[i] = ok ? q : (u32x4){0u, 0u, 0u, 0u}; }
}
__device__ __forceinline__ void conv_compute(const ConvIn& C, float (&o)[2][8]) {
    float xv[5][8];
#pragma unroll
    for (int i = 0; i < 5; ++i) { const u32x4 q = C.x[i]; xv[i][0] = bflo(q.x); xv[i][1] = bfhi(q.x); xv[i][2] = bflo(q.y); xv[i][3] = bfhi(q.y); xv[i][4] = bflo(q.z); xv[i][5] = bfhi(q.z); xv[i][6] = bflo(q.w); xv[i][7] = bfhi(q.w); }
#pragma unroll
    for (int r = 0; r < 2; ++r)
#pragma unroll
        for (int e = 0; e < 8; ++e) { float acc = C.b[e >> 2][e & 3];
#pragma unroll
            for (int j = 0; j < 4; ++j) acc += C.w[2 * j + (e >> 2)][e & 3] * xv[r + j][e];
            o[r][e] = siluf_(acc); }
}

__device__ __forceinline__ void p2_dc_task(const Args& a, LAS unsigned char* lds, int tid, int lane, int wave, int task) {
    unsigned char* ws = a.ws; const bf16* Z = (const bf16*)(ws + WS_Z);
    const int bh = task >> 6, c = task & 63, b = bh >> 2, h = bh & 3, tok0 = b * SEQ + c * 64;
    const float* AV = (const float*)(ws + WS_AV) + (size_t)bh * SEQ + c * 64;
    const float mp = m_prev_of((const float*)(ws + WS_BL), (const float*)(ws + WS_AM), bh, c);
    const float M63 = fmaxf(mp, ((const float*)(ws + WS_AM))[bh * 64 + c]);
    LAS bf16* KT = (LAS bf16*)lds; LAS bf16* VT = (LAS bf16*)(lds + 17408); LAS float* WG = (LAS float*)(lds + 34816);
    if (tid < 64) WG[tid] = __expf(AV[tid] - M63);
    const int cc = tid & 15, rp = tid >> 4, r0 = 2 * rp;
    ConvIn ck; conv_load(ck, Z, a.in[I_CW], a.in[I_CB], tok0, c * 64, r0, 512 + h * DH + 8 * cc);
    u32x4 vq[2]; float avr[2];
#pragma unroll
    for (int r = 0; r < 2; ++r) { vq[r] = *(const u32x4*)(Z + (size_t)(tok0 + r0 + r) * NZ + 1024 + h * DH + 8 * cc); avr[r] = AV[r0 + r]; }
    { float o[2][8]; conv_compute(ck, o);
#pragma unroll
      for (int r = 0; r < 2; ++r) { LAS unsigned* d = (LAS unsigned*)(KT + (r0 + r) * 136 + 8 * cc);
#pragma unroll
          for (int e = 0; e < 4; ++e) d[e] = pk2(o[r][2 * e] * 0.08838834764831845f, o[r][2 * e + 1] * 0.08838834764831845f); } }
#pragma unroll
    for (int r = 0; r < 2; ++r) { const float wg = __expf(avr[r] - M63);
        const u32x4 q = vq[r];
        LAS unsigned* d = (LAS unsigned*)(VT + (r0 + r) * 136 + 8 * cc);
        d[0] = pk2(bflo(q.x) * wg, bfhi(q.x) * wg); d[1] = pk2(bflo(q.y) * wg, bfhi(q.y) * wg); d[2] = pk2(bflo(q.z) * wg, bfhi(q.z) * wg); d[3] = pk2(bflo(q.w) * wg, bfhi(q.w) * wg); }
    __syncthreads();
    f32x4 acc[8];
#pragma unroll
    for (int n = 0; n < 8; ++n) acc[n] = (f32x4){0.f, 0.f, 0.f, 0.f};
#pragma unroll
    for (int kk = 0; kk < 2; ++kk) { const bf16x8 mf = ldfragT(VT, 136, 16 * wave, 32 * kk, lane);
#pragma unroll
        for (int n = 0; n < 8; ++n) { const bf16x8 nf = ldfragT(KT, 136, 16 * n, 32 * kk, lane); acc[n] = MMA16(nf, mf, acc[n]); } }
    bf16* DC = (bf16*)(ws + WS_DC) + ((size_t)task * DH + 16 * wave + (lane & 15)) * DH + 4 * (lane >> 4);
#pragma unroll
    for (int n = 0; n < 8; ++n) { u32x2 o; o.x = pk2(acc[n][0], acc[n][1]); o.y = pk2(acc[n][2], acc[n][3]); *(u32x2*)(DC + 16 * n) = o; }
    if (tid < DH) { float s = 0.f;
#pragma unroll 8
        for (int r = 0; r < 64; ++r) s += WG[r] * bf2f(KT[r * 136 + tid]);
        ((float*)(ws + WS_DN))[(size_t)task * DH + tid] = s; }
    __syncthreads();
}

__device__ __forceinline__ void p2_gmlp_task(const Args& a, LAS unsigned char* lds, int tid, int lane, int wave, int task) {
    unsigned char* ws = a.ws; const bf16* Z = (const bf16*)(ws + WS_Z); bf16* Y = (bf16*)(ws + WS_Y);
    const int g = task & 3, ck = (task >> 2) & 31, b = task >> 7, tok0 = b * SEQ + ck * 128;
    LAS bf16* VV = (LAS bf16*)lds; LAS bf16* WM = (LAS bf16*)(lds + 34816);
    { const int r = tid >> 2, qd = tid & 3; const bf16* src = Z + (size_t)(tok0 + r) * NZ + 2560 + g * 128 + 32 * qd; float v[32];
#pragma unroll
      for (int i = 0; i < 4; ++i) { const u32x4 q = *(const u32x4*)(src + 8 * i);
          v[8 * i + 0] = bflo(q.x); v[8 * i + 1] = bfhi(q.x); v[8 * i + 2] = bflo(q.y); v[8 * i + 3] = bfhi(q.y); v[8 * i + 4] = bflo(q.z); v[8 * i + 5] = bfhi(q.z); v[8 * i + 6] = bflo(q.w); v[8 * i + 7] = bfhi(q.w); }
      float s = 0.f;
#pragma unroll
      for (int i = 0; i < 32; ++i) s += v[i];
      s += __shfl_xor(s, 1); s += __shfl_xor(s, 2);
      const float mu = s * (1.f / 128.f); float q2 = 0.f;
#pragma unroll
      for (int i = 0; i < 32; ++i) { v[i] -= mu; q2 += v[i] * v[i]; }
      q2 += __shfl_xor(q2, 1); q2 += __shfl_xor(q2, 2);
      const float rstd = rsqrtf(q2 * (1.f / 128.f) + EPS);
      const float* lg = a.in[I_LNG] + g * 128 + 32 * qd; const float* lb = a.in[I_LNB] + g * 128 + 32 * qd;
      LAS unsigned* d = (LAS unsigned*)(VV + r * 136 + 32 * qd);
#pragma unroll
      for (int i = 0; i < 16; ++i) d[i] = pk2(v[2 * i] * rstd * lg[2 * i] + lb[2 * i], v[2 * i + 1] * rstd * lg[2 * i + 1] + lb[2 * i + 1]); }
    { const f32x4* wsrc = (const f32x4*)(a.in[I_WS] + (size_t)g * 128 * 128);
#pragma unroll
      for (int i = 0; i < 8; ++i) { const int idx = tid + NTHREADS * i, t = idx >> 5, s4 = (idx & 31) * 4; f32x4 w = wsrc[idx];
          if ((t >> 6) < (s4 >> 6)) w = (f32x4){0.f, 0.f, 0.f, 0.f};
          u32x2 o; o.x = pk2(w[0], w[1]); o.y = pk2(w[2], w[3]); *(LAS u32x2*)(WM + t * 136 + s4) = o; } }
    __syncthreads();
    f32x4 acc[8];
#pragma unroll
    for (int n = 0; n < 8; ++n) acc[n] = (f32x4){0.f, 0.f, 0.f, 0.f};
#pragma unroll
    for (int kk = 0; kk < 4; ++kk) { const bf16x8 mf = ldfrag(WM, 136, 16 * wave, 32 * kk, lane);
#pragma unroll
        for (int n = 0; n < 8; ++n) { const bf16x8 nf = ldfragT(VV, 136, 16 * n, 32 * kk, lane); acc[n] = MMA16(nf, mf, acc[n]); } }
    const int t = 16 * wave + (lane & 15), d0 = 4 * (lane >> 4); const float bias = a.in[I_BS][g * 128 + t];
    const bf16* up = Z + (size_t)(tok0 + t) * NZ + 2048 + g * 128 + d0; bf16* yp = Y + (size_t)(tok0 + t) * DM + 512 + g * 128 + d0;
#pragma unroll
    for (int n = 0; n < 8; ++n) { const u32x2 uq = *(const u32x2*)(up + 16 * n);
        u32x2 o; o.x = pk2(bflo(uq.x) * (acc[n][0] + bias), bfhi(uq.x) * (acc[n][1] + bias)); o.y = pk2(bflo(uq.y) * (acc[n][2] + bias), bfhi(uq.y) * (acc[n][3] + bias));
        *(u32x2*)(yp + 16 * n) = o; }
    __syncthreads();
}

__device__ __forceinline__ void p3_scan(const Args& a, LAS unsigned char* lds, int tid, int bid, int G) {
    unsigned char* ws = a.ws; const float* bL = (const float*)(ws + WS_BL); const float* am = (const float*)(ws + WS_AM);
    const unsigned* DC = (const unsigned*)(ws + WS_DC); unsigned* CP = (unsigned*)(ws + WS_CP);
    LAS float* DEC = (LAS float*)lds;
    for (int i = tid; i < NBH * 64; i += NTHREADS) { const int bh = i >> 6, c = i & 63; const float mp = m_scan_excl(bL, am, bh, c); DEC[i] = __expf(mp - fmaxf(mp, am[i])); }
    __syncthreads();
    for (int e2 = bid * NTHREADS + tid; e2 < NBH * DH * DH / 2; e2 += G * NTHREADS) {
        const int bh = e2 >> 13, el = e2 & 8191; float c0 = 0.f, c1 = 0.f;
#pragma unroll 16
        for (int c = 0; c < NCH; ++c) { const size_t o = ((size_t)(bh * NCH + c) << 13) + el;
            CP[o] = pk2(c0, c1); const unsigned d = DC[o]; const float dec = DEC[bh * 64 + c];
            c0 = dec * c0 + bflo(d); c1 = dec * c1 + bfhi(d); }
    }
    const float* DN = (const float*)(ws + WS_DN); float* NP = (float*)(ws + WS_NP);
    for (int e = bid * NTHREADS + tid; e < NBH * DH; e += G * NTHREADS) { const int bh = e >> 7, k = e & 127; float n = 0.f;
#pragma unroll 8
        for (int c = 0; c < NCH; ++c) { const size_t o = (size_t)(bh * NCH + c) * DH + k; NP[o] = n; n = DEC[bh * 64 + c] * n + DN[o]; } }
    __syncthreads();
}

__device__ __forceinline__ void p4_out_task(const Args& a, LAS unsigned char* lds, int tid, int lane, int wave, int task) {
    unsigned char* ws = a.ws; const bf16* Z = (const bf16*)(ws + WS_Z); bf16* Y = (bf16*)(ws + WS_Y);
    const int bh = task >> 6, c = task & 63, b = bh >> 2, h = bh & 3, tok0 = b * SEQ + c * 64;
    LAS bf16* QS = (LAS bf16*)lds; LAS bf16* KS = (LAS bf16*)(lds + 17408); LAS bf16* VS = (LAS bf16*)(lds + 34816); LAS bf16* CS = (LAS bf16*)(lds + 54272);
    LAS bf16* PS = (LAS bf16*)(lds + 93440); LAS float* NUM = (LAS float*)(lds + 102656); LAS float* AS = (LAS float*)(lds + 139776); LAS float* MT = AS + 64; LAS float* BT = AS + 128;
    const float mp = m_prev_of((const float*)(ws + WS_BL), (const float*)(ws + WS_AM), bh, c);
    const int cc = tid & 15, rp = tid >> 4, r0 = 2 * rp;
    ConvIn cq, ck; conv_load(cq, Z, a.in[I_CW], a.in[I_CB], tok0, c * 64, r0, h * DH + 8 * cc); conv_load(ck, Z, a.in[I_CW], a.in[I_CB], tok0, c * 64, r0, 512 + h * DH + 8 * cc);
    u32x4 vq[2], cq4[4];
#pragma unroll
    for (int r = 0; r < 2; ++r) vq[r] = *(const u32x4*)(Z + (size_t)(tok0 + r0 + r) * NZ + 1024 + h * DH + 8 * cc);
    { const u32x4* src = (const u32x4*)((const bf16*)(ws + WS_CP) + (size_t)task * DH * DH);
#pragma unroll
      for (int i = 0; i < 4; ++i) cq4[i] = src[tid + NTHREADS * i]; }
    { float o[2][8]; conv_compute(cq, o);
#pragma unroll
      for (int r = 0; r < 2; ++r) { u32x4 w; w.x = pk2(o[r][0], o[r][1]); w.y = pk2(o[r][2], o[r][3]); w.z = pk2(o[r][4], o[r][5]); w.w = pk2(o[r][6], o[r][7]); *(LAS u32x4*)(QS + (r0 + r) * 136 + 8 * cc) = w; } }
    { float o[2][8]; conv_compute(ck, o); const float sc = 0.08838834764831845f;
#pragma unroll
      for (int r = 0; r < 2; ++r) { u32x4 w; w.x = pk2(o[r][0] * sc, o[r][1] * sc); w.y = pk2(o[r][2] * sc, o[r][3] * sc); w.z = pk2(o[r][4] * sc, o[r][5] * sc); w.w = pk2(o[r][6] * sc, o[r][7] * sc); *(LAS u32x4*)(KS + (r0 + r) * 136 + 8 * cc) = w; } }
#pragma unroll
    for (int r = 0; r < 2; ++r) { const u32x4 q = vq[r];
        LAS unsigned* d = (LAS unsigned*)(VS + (r0 + r) * 152 + 8 * cc); d[0] = q.x; d[1] = q.y; d[2] = q.z; d[3] = q.w; }
    if (tid < 64) { LAS unsigned* d = (LAS unsigned*)(VS + tid * 152 + 128); d[0] = 0x00003F80u;
#pragma unroll
        for (int e = 1; e < 8; ++e) d[e] = 0u; }
#pragma unroll
    for (int i = 0; i < 4; ++i) { const int idx = tid + NTHREADS * i, v = idx >> 4, kc = idx & 15; *(LAS u32x4*)(CS + v * 136 + 8 * kc) = cq4[i]; }
    if (tid < DH) CS[128 * 136 + tid] = (bf16)(pk2(((const float*)(ws + WS_NP))[(size_t)task * DH + tid], 0.f) & 0xffffu);
    for (int i = tid; i < 15 * 68; i += NTHREADS) ((LAS unsigned*)(CS + 129 * 136))[i] = 0u;
    if (tid < 64) { const size_t o = (size_t)bh * SEQ + c * 64 + tid; const float av = ((const float*)(ws + WS_AV))[o]; float pm = av;
#pragma unroll
        for (int d = 1; d < 64; d <<= 1) { const float t = __shfl_up(pm, d); if (lane >= d) pm = fmaxf(pm, t); }
        AS[tid] = av; MT[tid] = fmaxf(mp, pm); BT[tid] = ((const float*)(ws + WS_BC))[o]; }
    __syncthreads();
    const int fr = lane & 15, fq = lane >> 4, mt = wave & 3, hf = wave >> 2, t = 16 * mt + fr;
    {
        const float Mt = MT[t];
#pragma unroll
        for (int nn = 0; nn < 2; ++nn) { const int nt = 2 * hf + nn; f32x4 acc = (f32x4){0.f, 0.f, 0.f, 0.f};
#pragma unroll
            for (int kk = 0; kk < 4; ++kk) acc = MMA16(ldfrag(KS, 136, 16 * nt, 32 * kk, lane), ldfrag(QS, 136, 16 * mt, 32 * kk, lane), acc);
            float p[4];
#pragma unroll
            for (int i = 0; i < 4; ++i) { const int s = 16 * nt + 4 * fq + i; p[i] = (s <= t) ? acc[i] * __expf(AS[s] - Mt) : 0.f; }
            u32x2 o; o.x = pk2(p[0], p[1]); o.y = pk2(p[2], p[3]); *(LAS u32x2*)(PS + t * 72 + 16 * nt + 4 * fq) = o; }
    }
    __syncthreads();
    {
        const int n0 = hf ? 5 : 0, cnt = hf ? 4 : 5;
        f32x4 a1[5], a2[5];
#pragma unroll
        for (int nn = 0; nn < 5; ++nn) { a1[nn] = (f32x4){0.f, 0.f, 0.f, 0.f}; a2[nn] = (f32x4){0.f, 0.f, 0.f, 0.f}; }
#pragma unroll
        for (int kk = 0; kk < 2; ++kk) { const bf16x8 mf = ldfrag(PS, 72, 16 * mt, 32 * kk, lane);
#pragma unroll
            for (int nn = 0; nn < 5; ++nn) if (nn < cnt) a1[nn] = MMA16(ldfragT(VS, 152, 16 * (n0 + nn), 32 * kk, lane), mf, a1[nn]); }
#pragma unroll
        for (int kk = 0; kk < 4; ++kk) { const bf16x8 mf = ldfrag(QS, 136, 16 * mt, 32 * kk, lane);
#pragma unroll
            for (int nn = 0; nn < 5; ++nn) if (nn < cnt) a2[nn] = MMA16(ldfrag(CS, 136, 16 * (n0 + nn), 32 * kk, lane), mf, a2[nn]); }
        const float sc = __expf(mp - MT[t]);
#pragma unroll
        for (int nn = 0; nn < 5; ++nn) if (nn < cnt) {
#pragma unroll
            for (int i = 0; i < 4; ++i) NUM[t * 145 + 16 * (n0 + nn) + 4 * fq + i] = a1[nn][i] + sc * a2[nn][i]; }
    }
    __syncthreads();
    {
        const int rr = lane >> 3, cq = lane & 7, tt = 8 * wave + rr; const size_t tok = (size_t)(tok0 + tt);
        const u32x4 oa = *(const u32x4*)(Z + tok * NZ + 1536 + h * DH + 16 * cq), ob = *(const u32x4*)(Z + tok * NZ + 1536 + h * DH + 16 * cq + 8);
        const float* ng = a.in[I_MNG] + h * DH + 16 * cq; f32x4 ngv[4];
#pragma unroll
        for (int j = 0; j < 4; ++j) ngv[j] = ((const f32x4*)ng)[j];
        const float den = NUM[tt * 145 + 128]; const float inv = 1.f / fmaxf(fabsf(den), __expf(-(BT[tt] + MT[tt])));
        float hv[16]; float ss = 0.f;
#pragma unroll
        for (int i = 0; i < 16; ++i) { hv[i] = NUM[tt * 145 + 16 * cq + i] * inv; ss += hv[i] * hv[i]; }
        ss += __shfl_xor(ss, 1); ss += __shfl_xor(ss, 2); ss += __shfl_xor(ss, 4);
        const float r = rsqrtf(ss * (1.f / DH) + EPS);
        float ov[16];
#pragma unroll
        for (int w = 0; w < 4; ++w) { ov[2 * w] = bflo(oa[w]); ov[2 * w + 1] = bfhi(oa[w]); ov[8 + 2 * w] = bflo(ob[w]); ov[8 + 2 * w + 1] = bfhi(ob[w]); }
        float y[16];
#pragma unroll
        for (int i = 0; i < 16; ++i) y[i] = hv[i] * r * ngv[i >> 2][i & 3] * sigmoidf_(ov[i]);
        u32x4 w0, w1;
#pragma unroll
        for (int w = 0; w < 4; ++w) { w0[w] = pk2(y[2 * w], y[2 * w + 1]); w1[w] = pk2(y[8 + 2 * w], y[8 + 2 * w + 1]); }
        bf16* yp = Y + tok * DM + h * DH + 16 * cq; *(u32x4*)yp = w0; *(u32x4*)(yp + 8) = w1;
    }
    __syncthreads();
}

struct TabRow { f32x4 v[4]; };
typedef int i32x2_t __attribute__((ext_vector_type(2)));
__device__ __forceinline__ void tab_load(const Args& a, int row, int lane, TabRow& R) {
    const bool isv = row >= NEXP; const int e = row & (NEXP - 1);
    const f32x4* src = (const f32x4*)((isv ? a.in[I_PV] : a.in[I_PU]) + (size_t)e * DM) + (isv ? 64 * (lane >> 4) + (lane & 15) : 4 * lane);
    const int st = isv ? 16 : 1;
#pragma unroll
    for (int j = 0; j < 4; ++j) R.v[j] = src[j * st];
}
__device__ __forceinline__ unsigned i4x8(const f32x4 a, const f32x4 b, float inv) {
    unsigned r = 0u;
#pragma unroll
    for (int k = 0; k < 8; ++k) { const float v = (k < 4 ? a[k & 3] : b[k & 3]) * inv; const unsigned bits = __float_as_uint(__builtin_amdgcn_fmed3f(v, -8.f, 7.f) + 12582912.f); r |= (bits & 15u) << (4 * k); }
    return r;
}
__device__ __forceinline__ void tab_finish(const Args& a, int row, int lane, TabRow& R, LAS unsigned char* tsc) {
    unsigned char* ws = a.ws; const bool isv = row >= NEXP; const int e = row & (NEXP - 1); float am = 0.f, sq = 0.f;
#pragma unroll
    for (int j = 0; j < 4; ++j) { if (!isv) R.v[j] = R.v[j] * ((const f32x4*)a.in[I_G2])[4 * lane + j]; am = fmaxf(am, fmaxf(fmaxf(fabsf(R.v[j][0]), fabsf(R.v[j][1])), fmaxf(fabsf(R.v[j][2]), fabsf(R.v[j][3]))));
        sq += (R.v[j][0] * R.v[j][0] + R.v[j][1] * R.v[j][1]) + (R.v[j][2] * R.v[j][2] + R.v[j][3] * R.v[j][3]); }
    am = wave_max(am);
    u32x2 o; float sc;
    if (isv) {
        sc = am > 0.f ? am * (1.f / 6.f) : 1.f; const float inv = 1.f / sc;
        unsigned r = 0u;
        r = __builtin_amdgcn_cvt_scalef32_pk_fp4_f32(r, R.v[0][0] * inv, R.v[0][1] * inv, 1.0f, 0); r = __builtin_amdgcn_cvt_scalef32_pk_fp4_f32(r, R.v[0][2] * inv, R.v[0][3] * inv, 1.0f, 1);
        r = __builtin_amdgcn_cvt_scalef32_pk_fp4_f32(r, R.v[1][0] * inv, R.v[1][1] * inv, 1.0f, 2); r = __builtin_amdgcn_cvt_scalef32_pk_fp4_f32(r, R.v[1][2] * inv, R.v[1][3] * inv, 1.0f, 3); o[0] = r; r = 0u;
        r = __builtin_amdgcn_cvt_scalef32_pk_fp4_f32(r, R.v[2][0] * inv, R.v[2][1] * inv, 1.0f, 0); r = __builtin_amdgcn_cvt_scalef32_pk_fp4_f32(r, R.v[2][2] * inv, R.v[2][3] * inv, 1.0f, 1);
        r = __builtin_amdgcn_cvt_scalef32_pk_fp4_f32(r, R.v[3][0] * inv, R.v[3][1] * inv, 1.0f, 2); r = __builtin_amdgcn_cvt_scalef32_pk_fp4_f32(r, R.v[3][2] * inv, R.v[3][3] * inv, 1.0f, 3); o[1] = r;
        *(LAS u32x2*)(tsc + 8 * lane) = o;
        const auto tr = __builtin_amdgcn_ds_read_tr4_b64_v2i32((LAS i32x2_t*)(tsc + 8 * lane));
        o[0] = (unsigned)tr[0]; o[1] = (unsigned)tr[1];
    } else {
        sq = wave_sum(sq); sc = fminf(am * (1.f / 7.f), 0.345f * sqrtf(sq * (1.f / DM))); sc = sc > 0.f ? sc : 1.f; const float inv = 1.f / sc;
        o[0] = i4x8(R.v[0], R.v[1], inv); o[1] = i4x8(R.v[2], R.v[3], inv);
    }
    *(u32x2*)(ws + (isv ? WS_VB : WS_UB) + (size_t)(lane >> 4) * (NEXP * 128) + (size_t)e * 128 + 8 * (lane & 15)) = o;
    if (lane == 0) ((float*)(ws + (isv ? WS_SV : WS_SU)))[e] = sc;
}

template <int N> __device__ __forceinline__ void bitonic_sort_desc(float (&v)[N]) {
#pragma unroll
    for (int k = 2; k <= N; k <<= 1)
#pragma unroll
        for (int j = k >> 1; j > 0; j >>= 1)
#pragma unroll
            for (int i = 0; i < N; ++i) { const int l = i ^ j; if (l > i) { const float mx = fmaxf(v[i], v[l]), mn = fminf(v[i], v[l]); if ((i & k) == 0) { v[i] = mx; v[l] = mn; } else { v[i] = mn; v[l] = mx; } } }
}
__device__ __forceinline__ void merge_top16(float (&a)[16], const float (&b)[16]) {
#pragma unroll
    for (int i = 0; i < 16; ++i) a[i] = fmaxf(a[i], b[15 - i]);
#pragma unroll
    for (int j = 8; j > 0; j >>= 1)
#pragma unroll
        for (int i = 0; i < 16; ++i) { const int l = i ^ j; if (l > i) { const float mx = fmaxf(a[i], a[l]), mn = fminf(a[i], a[l]); a[i] = mx; a[l] = mn; } }
}
constexpr int P7_SK = 0, P7_QS = 69632, P7_LS = P7_QS + 64 * 264 * 2, P7_OS = P7_LS + 64 * 33 * 4, P7_OE = P7_OS + 64 * 16 * 4, P7_END = P7_OE + 64 * 16 * 4;
constexpr int P7_TS = P7_END;
static_assert(P7_TS + 4 * 512 <= LDSCTL_OFF, "P7 LDS map");
__device__ __forceinline__ void p7_topk(const Args& a, LAS unsigned char* lds, int tid, int lane, int wave, int bid, int G) {
    unsigned char* ws = a.ws; const bf16* Q = (const bf16*)(ws + WS_Q);
    const int h = bid & 7, slot = bid >> 3, nslot = G >> 3;
    LAS bf16* SK = (LAS bf16*)(lds + P7_SK); LAS bf16* QS = (LAS bf16*)(lds + P7_QS); LAS float* LS = (LAS float*)(lds + P7_LS);
    { const u32x4* src = (const u32x4*)((const bf16*)(ws + WS_SKB) + (size_t)h * 2 * PKEYS * 128);
#pragma unroll
      for (int i = 0; i < 8; ++i) { const int idx = tid + NTHREADS * i, r = idx >> 4, cc = idx & 15; *(LAS u32x4*)(SK + r * 136 + 8 * cc) = src[idx]; } }
    const int fr = lane & 15, fq = lane >> 4, mt = wave & 3, p = wave >> 2;
    LAS unsigned char* tsc = lds + P7_TS + 512 * (wave & 3);
    constexpr int TCH = 8;
    const int tstride = TCH * G * 4; int it = 0;
    u32x4 qpre[4];
    if (slot < T / 64) {
#pragma unroll
        for (int i = 0; i < 4; ++i) { const int idx = tid + NTHREADS * i, r = idx >> 5, cc = idx & 31; qpre[i] = *(const u32x4*)(Q + (size_t)(slot * 64 + r) * 2048 + h * PQD + 8 * cc); } }
    for (int tile = slot; tile < T / 64; tile += nslot, ++it) {
        const int tokb = tile * 64;
#pragma unroll
        for (int i = 0; i < 4; ++i) { const int idx = tid + NTHREADS * i, r = idx >> 5, cc = idx & 31; *(LAS u32x4*)(QS + r * 264 + 8 * cc) = qpre[i]; }
        __syncthreads();
        if (tile + nslot < T / 64) {
#pragma unroll
            for (int i = 0; i < 4; ++i) { const int idx = tid + NTHREADS * i, r = idx >> 5, cc = idx & 31; qpre[i] = *(const u32x4*)(Q + (size_t)((tile + nslot) * 64 + r) * 2048 + h * PQD + 8 * cc); } }
        const int trow0 = (it * G + bid) * 4 + (wave - 4); TabRow tr0, tr1, tr2, tr3;
        const bool tdo = wave >= 4 && it < TCH;
        if (tdo) { if (trow0 < 2 * NEXP) tab_load(a, trow0, lane, tr0); if (trow0 + tstride < 2 * NEXP) tab_load(a, trow0 + tstride, lane, tr1); if (trow0 + 2 * tstride < 2 * NEXP) tab_load(a, trow0 + 2 * tstride, lane, tr2);
                   if (trow0 + 3 * tstride < 2 * NEXP) tab_load(a, trow0 + 3 * tstride, lane, tr3); }
        {
            f32x4 acc[8];
#pragma unroll
            for (int n = 0; n < 8; ++n) acc[n] = (f32x4){0.f, 0.f, 0.f, 0.f};
#pragma unroll
            for (int kk = 0; kk < 4; ++kk) { const bf16x8 mf = ldfrag(QS, 264, 16 * mt, 128 * p + 32 * kk, lane);
#pragma unroll
                for (int n = 0; n < 8; ++n) acc[n] = MMA16(ldfrag(SK + p * 128 * 136, 136, 16 * n, 32 * kk, lane), mf, acc[n]); }
            float v[32];
#pragma unroll
            for (int n = 0; n < 8; ++n)
#pragma unroll
                for (int i = 0; i < 4; ++i) v[4 * n + i] = __uint_as_float((__float_as_uint(acc[n][i]) & 0xffffff80u) | (unsigned)(16 * n + 4 * fq + i));
            bitonic_sort_desc<32>(v);
            float top[16], oth[16];
#pragma unroll
            for (int i = 0; i < 16; ++i) top[i] = v[i];
#pragma unroll
            for (int i = 0; i < 16; ++i) oth[i] = __shfl_xor(top[i], 16);
            merge_top16(top, oth);
#pragma unroll
            for (int i = 0; i < 16; ++i) oth[i] = __shfl_xor(top[i], 32);
            merge_top16(top, oth);
            if (fq == 0) {
#pragma unroll
                for (int i = 0; i < 16; ++i) LS[(16 * mt + fr) * 33 + p * 16 + i] = top[i]; }
        }
        __syncthreads();
        if (tdo) { if (trow0 < 2 * NEXP) tab_finish(a, trow0, lane, tr0, tsc); if (trow0 + tstride < 2 * NEXP) tab_finish(a, trow0 + tstride, lane, tr1, tsc); if (trow0 + 2 * tstride < 2 * NEXP) tab_finish(a, trow0 + 2 * tstride, lane, tr2, tsc);
                   if (trow0 + 3 * tstride < 2 * NEXP) tab_finish(a, trow0 + 3 * tstride, lane, tr3, tsc); }
        if (wave < 4) {
            const int tl = 16 * wave + (lane >> 2), u = lane & 3;
            const LAS float* L1 = LS + tl * 33; const LAS float* L2 = L1 + 16; LAS float* OS = (LAS float*)(lds + P7_OS) + tl * 16; LAS int* OE = (LAS int*)(lds + P7_OE) + tl * 16;
            float s1v[4], hd[4], k2c[4]; int bpk = 0; const float s20 = L2[0];
#pragma unroll
            for (int j = 0; j < 4; ++j) { s1v[j] = L1[u + 4 * j]; k2c[j] = s20; hd[j] = s1v[j] + s20; }
#pragma unroll 1
            for (int r = 0; r < 16; ++r) {
                const float lm = fmaxf(fmaxf(hd[0], hd[1]), fmaxf(hd[2], hd[3]));
                const int jl = hd[0] == lm ? 0 : hd[1] == lm ? 1 : hd[2] == lm ? 2 : 3;
                float m = fmaxf(lm, __int_as_float(__builtin_amdgcn_mov_dpp(__float_as_int(lm), 0xB1, 0xf, 0xf, true)));
                m = fmaxf(m, __int_as_float(__builtin_amdgcn_mov_dpp(__float_as_int(m), 0x4E, 0xf, 0xf, true)));
                int f = (lm == m) ? u : 4; f = min(f, __builtin_amdgcn_mov_dpp(f, 0xB1, 0xf, 0xf, true)); f = min(f, __builtin_amdgcn_mov_dpp(f, 0x4E, 0xf, 0xf, true));
                if (f == u) {
                    const int b = (bpk >> (8 * jl)) & 255, nb = b + 1, av = u + 4 * jl;
                    const float k1 = jl == 0 ? s1v[0] : jl == 1 ? s1v[1] : jl == 2 ? s1v[2] : s1v[3], k2 = jl == 0 ? k2c[0] : jl == 1 ? k2c[1] : jl == 2 ? k2c[2] : k2c[3];
                    OS[r] = m; OE[r] = (int)(__float_as_uint(k1) & 127u) * PKEYS + (int)(__float_as_uint(k2) & 127u);
                    const bool ok = (av + 1) * (nb + 1) <= 16; const float k2n = L2[ok ? nb : 0]; const float nv = ok ? k1 + k2n : -INFINITY;
                    bpk += 1 << (8 * jl);
#pragma unroll
                    for (int j = 0; j < 4; ++j) { hd[j] = (j == jl) ? nv : hd[j]; k2c[j] = (j == jl) ? k2n : k2c[j]; }
                }
            }
            const f32x4 sv = *(const LAS f32x4*)(OS + 4 * u); const float mx = OS[0];
            f32x4 ev; float sum = 0.f;
#pragma unroll
            for (int i = 0; i < 4; ++i) { ev[i] = __expf(sv[i] - mx); sum += ev[i]; }
            sum += __int_as_float(__builtin_amdgcn_mov_dpp(__float_as_int(sum), 0xB1, 0xf, 0xf, true)); sum += __int_as_float(__builtin_amdgcn_mov_dpp(__float_as_int(sum), 0x4E, 0xf, 0xf, true));
            const float inv = 1.f / sum; const size_t o = (size_t)(tokb + tl) * 128 + h * 16 + 4 * u;
            const u32x4 ev4 = *(const LAS u32x4*)(OE + 4 * u);
            *(u32x4*)((int*)(ws + WS_IDX) + o) = ev4;
            { int* iv = (int*)(ws + WS_IDXV) + (size_t)(tokb + tl) * 128 + 32 * (h >> 1) + 16 * (u & 1) + 2 * (h & 1) + (u >> 1);
              iv[0] = (int)ev4[0]; iv[4] = (int)ev4[1]; iv[8] = (int)ev4[2]; iv[12] = (int)ev4[3]; }
            *(f32x4*)((float*)(ws + WS_GATE) + o) = ev * inv;
        }
    }
    if (wave >= 4) for (; it < TCH; ++it) { const int trow0 = (it * G + bid) * 4 + (wave - 4);
        for (int row = trow0; row < 2 * NEXP; row += tstride) { TabRow tr; tab_load(a, row, lane, tr); tab_finish(a, row, lane, tr, tsc); } }
    if (wave >= 4 && 4 * tstride < 2 * NEXP) for (int it2 = 0; it2 < TCH; ++it2)
        for (int row = (it2 * G + bid) * 4 + (wave - 4) + 4 * tstride; row < 2 * NEXP; row += tstride) { TabRow tr; tab_load(a, row, lane, tr); tab_finish(a, row, lane, tr, tsc); }
    __syncthreads();
}

struct Rows8 { u32x4 r[8]; };
template <int HB> __device__ __forceinline__ void issue8(Rows8& R, const unsigned char* ubase, unsigned loff, const u32x4 (&e)[4]) {
#pragma unroll
    for (int i = 0; i < 8; ++i) R.r[i] = *(const u32x4*)(ubase + (size_t)((e[2 * HB + (i >> 2)][i & 3] << 7) + loff));
}
__device__ __forceinline__ void fp4x8h(unsigned dw, f16x2 (&f)[4]) {
    f[0] = __builtin_amdgcn_cvt_scalef32_pk_f16_fp4(dw, 1.0f, 0); f[1] = __builtin_amdgcn_cvt_scalef32_pk_f16_fp4(dw, 1.0f, 1);
    f[2] = __builtin_amdgcn_cvt_scalef32_pk_f16_fp4(dw, 1.0f, 2); f[3] = __builtin_amdgcn_cvt_scalef32_pk_f16_fp4(dw, 1.0f, 3);
}
template <int OFF> __device__ __forceinline__ void dot8(const Rows8& R, const unsigned (&xh)[4], const unsigned (&xl)[4], int (&d)[16]) {
#pragma unroll
    for (int i = 0; i < 8; ++i) { int s = 0;
#pragma unroll
        for (int w = 0; w < 4; ++w) s = __builtin_amdgcn_sdot8((int)R.r[i][w], (int)xh[w], s, false);
        s <<= 4;
#pragma unroll
        for (int w = 0; w < 4; ++w) s = __builtin_amdgcn_sdot8((int)R.r[i][w], (int)xl[w], s, false);
        d[OFF + i] = s; }
}
template <int HB> __device__ __forceinline__ void fma8(const Rows8& R, const u32x4 (&cv)[4], f16x2 (&acch)[16]) {
#pragma unroll
    for (int i = 0; i < 8; ++i) { unsigned cb = cv[2 * HB + (i >> 2)][i & 3]; asm volatile("" : "+v"(cb)); const f16x2 c2 = __builtin_bit_cast(f16x2, cb);
#pragma unroll
        for (int w = 0; w < 4; ++w) { f16x2 f[4]; fp4x8h(R.r[i][w], f);
#pragma unroll
            for (int b = 0; b < 4; ++b) acch[4 * w + b] = __builtin_elementwise_fma(f[b], c2, acch[4 * w + b]); }
        if (i & 1) __builtin_amdgcn_sched_barrier(0); }
}
__device__ __forceinline__ void bfly32(float (&v)[32], int rank) {
#pragma unroll
    for (int j = 0; j < 16; ++j) { const auto r = __builtin_amdgcn_permlane32_swap(__float_as_uint(v[j]), __float_as_uint(v[16 + j]), false, false); v[j] = __uint_as_float(r[0]) + __uint_as_float(r[1]); }
#pragma unroll
    for (int j = 0; j < 8; ++j) { const auto r = __builtin_amdgcn_permlane16_swap(__float_as_uint(v[j]), __float_as_uint(v[8 + j]), false, false); v[j] = __uint_as_float(r[0]) + __uint_as_float(r[1]); }
    { const bool b = rank & 1;
#pragma unroll
      for (int j = 0; j < 4; ++j) { const float keep = b ? v[4 + j] : v[j], send = b ? v[j] : v[4 + j]; v[j] = keep + __int_as_float(__builtin_amdgcn_update_dpp(0, __float_as_int(send), 0x128, 0xf, 0xf, false)); } }
}
#define P8_PIN __builtin_amdgcn_sched_barrier(0)
constexpr int NSL = 4;
__device__ __forceinline__ void p8a_u(const Args& a, LAS unsigned char* lds, int lane, int wave, int bid, int G) {
    unsigned char* ws = a.ws; const int slice = bid & 3, half = (bid >> 2) & 1, wsl = (bid >> 3) * NWAVES + wave, nws = (G >> 3) * NWAVES, g = lane >> 3, q = lane & 7;
    const unsigned char* U4 = ws + WS_UB; const unsigned loff = slice * (NEXP * 128) + 16 * q; const bf16* XB1 = (const bf16*)(ws + WS_XB1) + 256 * slice + 32 * q + 4 * g; const unsigned* IDX = (const unsigned*)(ws + WS_IDX) + 16 * g;
    float* AP = (float*)(ws + WS_APART) + (size_t)slice * T * 128;
    LAS unsigned* XS = (LAS unsigned*)(lds + wave * 256);
    const int tend = (half + 1) * (T / 2);
    int t = half * (T / 2) + wsl; if (t >= tend) return;
    u32x4 e[4]; u32x2 xw = *(const u32x2*)(XB1 + (size_t)t * DM);
#pragma unroll
    for (int j = 0; j < 4; ++j) e[j] = *(const u32x4*)(IDX + (size_t)t * 128 + 4 * j);
    Rows8 A, B; issue8<0>(A, U4, loff, e);
    for (; t < tend; t += nws) {
        const int tn = (t + nws < tend) ? t + nws : t;
        u32x4 en[4];
#pragma unroll
        for (int j = 0; j < 4; ++j) en[j] = *(const u32x4*)(IDX + (size_t)tn * 128 + 4 * j);
        const u32x2 xwn = *(const u32x2*)(XB1 + (size_t)tn * DM);
        issue8<1>(B, U4, loff, e);
        P8_PIN;
        unsigned xh[4], xl[4]; float sx;
        {
            const float x0 = bflo(xw[0]), x1 = bfhi(xw[0]), x2 = bflo(xw[1]), x3 = bfhi(xw[1]);
            const float am = wave_max(fmaxf(fmaxf(fabsf(x0), fabsf(x1)), fmaxf(fabsf(x2), fabsf(x3))));
            sx = am > 0.f ? am * (1.f / 119.f) : 1.f; const float inv = 1.f / sx; constexpr float MG = 12582912.f + 8.f;
            const unsigned u0 = __float_as_uint(fmaf(x0, inv, MG)), u1 = __float_as_uint(fmaf(x1, inv, MG)), u2 = __float_as_uint(fmaf(x2, inv, MG)), u3 = __float_as_uint(fmaf(x3, inv, MG));
            unsigned W = __builtin_amdgcn_perm(u1, u0, 0x0c0c0400u); W = __builtin_amdgcn_perm(u2, W, 0x0c040100u); W = __builtin_amdgcn_perm(u3, W, 0x04020100u);
            unsigned H = (W >> 4) & 0x0F0F0F0Fu, L = (W & 0x0F0F0F0Fu) ^ 0x08080808u;
            H |= H >> 4; L |= L >> 4;
            XS[8 * q + g] = __builtin_amdgcn_perm(L, H, 0x06040200u);
            const u32x4 d0 = *(const LAS u32x4*)(XS + 8 * q), d1 = *(const LAS u32x4*)(XS + 8 * q + 4);
            xh[0] = __builtin_amdgcn_perm(d0[1], d0[0], 0x05040100u); xl[0] = __builtin_amdgcn_perm(d0[1], d0[0], 0x07060302u);
            xh[1] = __builtin_amdgcn_perm(d0[3], d0[2], 0x05040100u); xl[1] = __builtin_amdgcn_perm(d0[3], d0[2], 0x07060302u);
            xh[2] = __builtin_amdgcn_perm(d1[1], d1[0], 0x05040100u); xl[2] = __builtin_amdgcn_perm(d1[1], d1[0], 0x07060302u);
            xh[3] = __builtin_amdgcn_perm(d1[3], d1[2], 0x05040100u); xl[3] = __builtin_amdgcn_perm(d1[3], d1[2], 0x07060302u);
        }
        int d[16];
        dot8<0>(A, xh, xl, d);
        P8_PIN;
        issue8<0>(A, U4, loff, en);
        P8_PIN;
        dot8<8>(B, xh, xl, d);
        bfly16i<4, 2, 1>(d, q);
        *(f32x2*)(AP + (size_t)t * 128 + 16 * g + 2 * q) = (f32x2){(float)d[0] * sx, (float)d[1] * sx};
#pragma unroll
        for (int j = 0; j < 4; ++j) e[j] = en[j];
        xw = xwn;
    }
}
__device__ __forceinline__ void p8m_coef(const Args& a, int tid, int bid, int G) {
    unsigned char* ws = a.ws; const int* IDX = (const int*)(ws + WS_IDX); const float* GATE = (const float*)(ws + WS_GATE);
    const float* AP = (const float*)(ws + WS_APART); const float* SU = (const float*)(ws + WS_SU); const float* SV = (const float*)(ws + WS_SV); const float* SSP = (const float*)(ws + WS_SSP);
    unsigned char* C8 = ws + WS_COEF; float* OS = (float*)(ws + WS_COEF_OS);
    for (int i = bid * NTHREADS + tid; i < T * NSL; i += G * NTHREADS) ((unsigned*)(ws + WS_SSP2))[i] = 0xFFFFFFFFu;
    for (int i = bid * NTHREADS + tid; i < T * 128 / 4; i += G * NTHREADS) {
        const int t = i >> 5, k = i & 31; f32x4 s = (f32x4){0.f, 0.f, 0.f, 0.f};
#pragma unroll
        for (int sl = 0; sl < NSL; ++sl) s += ((const f32x4*)(AP + (size_t)sl * T * 128))[i];
        const u32x4 e = ((const u32x4*)IDX)[i]; const f32x4 gt = ((const f32x4*)GATE)[i]; const float rs2 = row_rs2(SSP, t);
        float c[4]; float cm = 0.f;
#pragma unroll
        for (int u = 0; u < 4; ++u) { c[u] = gelu_tanh(rs2 * SU[e[u]] * s[u]) * gt[u] * SV[e[u]]; cm = fmaxf(cm, fabsf(c[u])); }
        cm = fmaxf(cm, __shfl_xor(cm, 1)); cm = fmaxf(cm, __shfl_xor(cm, 2)); cm = fmaxf(cm, __shfl_xor(cm, 4)); cm = fmaxf(cm, __shfl_xor(cm, 8)); cm = fmaxf(cm, __shfl_xor(cm, 16));
        const float sc = cm > 0.f ? 240.f / cm : 1.f;
        float v[4];
#pragma unroll
        for (int u = 0; u < 4; ++u) v[u] = c[u] * sc;
        int w0 = __builtin_amdgcn_cvt_pk_fp8_f32(v[0], v[1], 0, false); w0 = __builtin_amdgcn_cvt_pk_fp8_f32(v[2], v[3], w0, true);
        v[0] -= __builtin_amdgcn_cvt_f32_fp8(w0, 0); v[1] -= __builtin_amdgcn_cvt_f32_fp8(w0, 1); v[2] -= __builtin_amdgcn_cvt_f32_fp8(w0, 2); v[3] -= __builtin_amdgcn_cvt_f32_fp8(w0, 3);
        int w1 = __builtin_amdgcn_cvt_pk_fp8_f32(v[0], v[1], 0, false); w1 = __builtin_amdgcn_cvt_pk_fp8_f32(v[2], v[3], w1, true);
        v[0] -= __builtin_amdgcn_cvt_f32_fp8(w1, 0); v[1] -= __builtin_amdgcn_cvt_f32_fp8(w1, 1); v[2] -= __builtin_amdgcn_cvt_f32_fp8(w1, 2); v[3] -= __builtin_amdgcn_cvt_f32_fp8(w1, 3);
        int w2 = __builtin_amdgcn_cvt_pk_fp8_f32(v[0], v[1], 0, false); w2 = __builtin_amdgcn_cvt_pk_fp8_f32(v[2], v[3], w2, true);
        int* dst = (int*)(C8 + (size_t)t * 384) + k;
        dst[0] = w0; dst[32] = w1; dst[64] = w2;
        if (k == 0) OS[t] = cm > 0.f ? cm * (1.f / 240.f) : 1.f; }
}
typedef int i32x2 __attribute__((ext_vector_type(2)));
typedef int i32x8 __attribute__((ext_vector_type(8)));
__device__ __forceinline__ void v_finalize4(float* orow, unsigned* S2u, int tok, unsigned w, const float (&xp)[16], const float (&gf)[16], int lane) {
    unsigned spins = 0;
    while (!__all(w != 0xFFFFFFFFu)) { w = __hip_atomic_load(S2u + (size_t)tok * NSL + (lane & 3), __ATOMIC_RELAXED, __HIP_MEMORY_SCOPE_AGENT); if (__all(w != 0xFFFFFFFFu)) break; __builtin_amdgcn_s_sleep(2); if (++spins > (1u << 20)) break; }
    const int wi = (int)w;
    const float sm = (__int_as_float(__builtin_amdgcn_mov_dpp(wi, 0x00, 0xf, 0xf, true)) + __int_as_float(__builtin_amdgcn_mov_dpp(wi, 0x55, 0xf, 0xf, true)))
                   + (__int_as_float(__builtin_amdgcn_mov_dpp(wi, 0xAA, 0xf, 0xf, true)) + __int_as_float(__builtin_amdgcn_mov_dpp(wi, 0xFF, 0xf, 0xf, true)));
    const float r = rsqrtf(sm * (1.f / DM) + EPS);
#pragma unroll
    for (int j = 0; j < 4; ++j) ((f32x4*)orow)[16 * j] = (f32x4){xp[4 * j] * r * gf[4 * j], xp[4 * j + 1] * r * gf[4 * j + 1], xp[4 * j + 2] * r * gf[4 * j + 2], xp[4 * j + 3] * r * gf[4 * j + 3]};
}
__device__ __forceinline__ void p8b_v(const Args& a, LAS unsigned char* lds, int lane, int wave, int bid, int G) {
    unsigned char* ws = a.ws; const int slice = bid & 3, half = (bid >> 2) & 1, wsl = (bid >> 3) * NWAVES + wave, nws = (G >> 3) * NWAVES;
    const int n = lane & 15, fq = lane >> 4, r8 = lane >> 3, c8 = lane & 7;
    LAS unsigned char* buf = lds + wave * 16384;
    const unsigned char* V4s = ws + WS_VB + (size_t)slice * (NEXP * 128) + 16 * (c8 ^ r8);
    const unsigned* IDX = (const unsigned*)(ws + WS_IDXV) + 4 * r8; const unsigned char* C8 = ws + WS_COEF; const float* OS = (const float*)(ws + WS_COEF_OS);
    const bf16* XB1 = (const bf16*)(ws + WS_XB1) + 256 * slice + 4 * n; unsigned* S2u = (unsigned*)(ws + WS_SSP2);
    const int ai = n & 3, af = n >> 2;
    const bool aact = ai < 3 && (af & 1) == (fq >> 1), ahi = af >= 2;
    const unsigned aoff = ai * 128 + 16 * (fq & 1);
    const unsigned tb0 = (unsigned)(32 * fq + n) * 128u + ((unsigned)(lane & 7) << 4);
    float gf[16];
#pragma unroll
    for (int nb = 0; nb < 16; ++nb) gf[nb] = a.in[I_GF][256 * slice + 64 * (nb >> 2) + 4 * n + (nb & 3)];
    int tp = -1; float xp[16];
#pragma unroll
    for (int nb = 0; nb < 16; ++nb) xp[nb] = 0.f;
    u32x4 id[4];
    if (wsl < T / 8) {
#pragma unroll
        for (int f = 0; f < 4; ++f) id[f] = *(const u32x4*)(IDX + (size_t)(half * (T / 2) + 4 * wsl + f) * 128); }
    for (int task = wsl; task < T / 8; task += nws) {
        const int tb = half * (T / 2) + 4 * task;
        f32x4 acc[16];
#pragma unroll
        for (int nb = 0; nb < 16; ++nb) acc[nb] = (f32x4){0.f, 0.f, 0.f, 0.f};
        const int tbn = task + nws < T / 8 ? tb + 4 * nws : tb;
        u32x4 xw0 = (u32x4){0u, 0u, 0u, 0u}, xw1 = xw0; float os = 0.f; unsigned pw = 0u;
#pragma unroll 1
        for (int s = 0; s < 4; ++s) {
            asm volatile("s_waitcnt lgkmcnt(0)" ::: "memory");
#pragma unroll
            for (int ii = 0; ii < 16; ++ii)
                __builtin_amdgcn_global_load_lds((const unsigned*)(V4s + ((size_t)id[ii >> 2][ii & 3] << 7)), (LAS unsigned*)(buf + ii * 1024), 16, 0, 0);
            u32x4 idn[4];
            { const unsigned* ip = IDX + (s < 3 ? (size_t)tb * 128 + 32 * (s + 1) : (size_t)tbn * 128);
#pragma unroll
              for (int f = 0; f < 4; ++f) idn[f] = *(const u32x4*)(ip + f * 128); }
            u32x4 cvec = (u32x4){0u, 0u, 0u, 0u};
            if (aact) cvec = *(const u32x4*)(C8 + (size_t)(tb + af) * 384 + aoff + 32 * s);
            if (s == 3) { const bf16* xr = XB1 + (size_t)(tb + fq) * DM; const u32x2 q0 = *(const u32x2*)xr, q1 = *(const u32x2*)(xr + 64), q2 = *(const u32x2*)(xr + 128), q3 = *(const u32x2*)(xr + 192);
                xw0 = (u32x4){q0[0], q0[1], q1[0], q1[1]}; xw1 = (u32x4){q2[0], q2[1], q3[0], q3[1]}; os = OS[tb + fq]; }
            if (s == 0 && tp >= 0) pw = __hip_atomic_load(S2u + (size_t)(tp + fq) * NSL + (lane & 3), __ATOMIC_RELAXED, __HIP_MEMORY_SCOPE_AGENT);
            asm volatile("s_waitcnt vmcnt(0)" ::: "memory");
            i32x8 A;
#pragma unroll
            for (int w = 0; w < 4; ++w) { A[w] = ahi ? 0 : (int)cvec[w]; A[4 + w] = ahi ? (int)cvec[w] : 0; }
#pragma unroll
            for (int nb = 0; nb < 16; ++nb) {
                const unsigned ad = (tb0 ^ (unsigned)((nb >> 1) << 4)) + 8u * (nb & 1);
                const i32x2 b0 = __builtin_amdgcn_ds_read_tr4_b64_v2i32((LAS i32x2*)(buf + ad)), b1 = __builtin_amdgcn_ds_read_tr4_b64_v2i32((LAS i32x2*)(buf + ad + 16 * 128));
                const i32x8 B = {b0[0], b0[1], b1[0], b1[1], 0, 0, 0, 0};
                acc[nb] = __builtin_amdgcn_mfma_scale_f32_16x16x128_f8f6f4(A, B, acc[nb], 0, 4, 0, 0x7F7F7F7F, 0, 0x7F7F7F7F);
            }
            asm volatile("" ::: "memory");
#pragma unroll
            for (int f = 0; f < 4; ++f) id[f] = idn[f];
            if (s == 0 && tp >= 0) v_finalize4(a.out + (size_t)(tp + fq) * DM + 256 * slice + 4 * n, S2u, tp + fq, pw, xp, gf, lane);
        }
        float ss = 0.f;
#pragma unroll
        for (int nb = 0; nb < 16; ++nb) { const unsigned xw = nb < 8 ? xw0[nb >> 1] : xw1[(nb - 8) >> 1]; const float x2 = ((nb & 1) ? bfhi(xw) : bflo(xw)) + ((acc[nb][0] + acc[nb][1]) + acc[nb][2]) * os; xp[nb] = x2; ss += x2 * x2; }
        ss += __int_as_float(__builtin_amdgcn_mov_dpp(__float_as_int(ss), 0xB1, 0xf, 0xf, true)); ss += __int_as_float(__builtin_amdgcn_mov_dpp(__float_as_int(ss), 0x4E, 0xf, 0xf, true));
        ss += __int_as_float(__builtin_amdgcn_update_dpp(0, __float_as_int(ss), 0x124, 0xf, 0xf, false)); ss += __int_as_float(__builtin_amdgcn_update_dpp(0, __float_as_int(ss), 0x128, 0xf, 0xf, false));
        if (n == 0) __hip_atomic_store(S2u + (size_t)(tb + fq) * NSL + slice, __float_as_uint(ss), __ATOMIC_RELAXED, __HIP_MEMORY_SCOPE_AGENT);
        tp = tb;
    }
    if (tp >= 0) v_finalize4(a.out + (size_t)(tp + fq) * DM + 256 * slice + 4 * n, S2u, tp + fq, 0xFFFFFFFFu, xp, gf, lane);
}
__device__ __forceinline__ void p9_final(const Args& a, int lane, int gw, int NGW) {
    const float* S2 = (const float*)(a.ws + WS_SSP2); const bf16* X2 = (const bf16*)(a.ws + WS_XB1);
    f32x4 gfv[4];
#pragma unroll
    for (int j = 0; j < 4; ++j) gfv[j] = ((const f32x4*)a.in[I_GF])[4 * lane + j];
#pragma unroll 2
    for (int tok = gw; tok < T; tok += NGW) {
        const f32x4 p0 = *(const f32x4*)(S2 + (size_t)tok * NSL);
        const float r = rsqrtf(((p0[0] + p0[1]) + (p0[2] + p0[3])) * (1.f / DM) + EPS);
        const u32x4 xa = *(const u32x4*)(X2 + (size_t)tok * DM + 16 * lane), xb = *(const u32x4*)(X2 + (size_t)tok * DM + 16 * lane + 8);
        f32x4* orow = (f32x4*)(a.out + (size_t)tok * DM) + 4 * lane;
        orow[0] = (f32x4){bflo(xa[0]), bfhi(xa[0]), bflo(xa[1]), bfhi(xa[1])} * r * gfv[0];
        orow[1] = (f32x4){bflo(xa[2]), bfhi(xa[2]), bflo(xa[3]), bfhi(xa[3])} * r * gfv[1];
        orow[2] = (f32x4){bflo(xb[0]), bfhi(xb[0]), bflo(xb[1]), bfhi(xb[1])} * r * gfv[2];
        orow[3] = (f32x4){bflo(xb[2]), bfhi(xb[2]), bflo(xb[3]), bfhi(xb[3])} * r * gfv[3];
    }
}

__global__ void __launch_bounds__(NTHREADS, 2) mk_fwd(Args a) {
    extern __shared__ __attribute__((aligned(16))) unsigned char lds_raw[];
    LAS unsigned char* lds = (LAS unsigned char*)lds_raw;
    const int tid = threadIdx.x, lane = tid & 63, wave = __builtin_amdgcn_readfirstlane(tid >> 6), bid = blockIdx.x, G = gridDim.x;
    unsigned char* ws = a.ws; unsigned* ctl = (unsigned*)(ws + WS_CTL);
    volatile LAS unsigned* MISC = (volatile LAS unsigned*)(lds + LDSCTL_OFF);
    for (int u = tid; u < 64; u += NTHREADS) MISC[u] = 0u;
    __syncthreads();
    XcdBarrier bar; bar.bar = ctl + CW_BAR; bar.x = 0; bar.st = nullptr;
    if (N_LAUNCHES == 1) bar = xcd_barrier_post(ctl + CW_BAR, MISC + 8);
    const int lo = a.ph_lo, hi = a.ph_hi;
#ifndef REP_PHASE
#define REP_PHASE -1
#endif
#define IN(k) (lo <= (k) && (k) < hi)
#define REP(k) for (int rep_ = 0; rep_ < ((REP_PHASE) == (k) ? 2 : 1); ++rep_)
#define SEAM(k) do { if (IN(k) && IN((k) + 1)) xcd_barrier(bar); } while (0)
    const int gw = bid * NWAVES + wave, NGW = G * NWAVES;

    if (IN(0)) { REP(0) { p0_prologue(a, lds, tid, lane, wave, bid, G); __syncthreads(); } SEAM(0); }
    if (IN(1)) { REP(1) {
        p1_stats(a, lane, gw);
        pg8::Gemm g{(const bf16*)(ws + WS_XB), (const bf16*)(ws + WS_W1T), T, NZ, DM}; pg8::StaticOrder S; S.init(T, NZ, G, bid);
        EpiZ E{(bf16*)(ws + WS_Z), NZ, (const float*)(ws + WS_RS1), 8};
        pg8::gemm_phase<EpiZ, pg8::StaticOrder, true, true>(lds, g, S, E); }
        SEAM(1);
    }
    if (IN(2)) { REP(2)
        for (int task = bid; task < NBH * NCH + 512; task += G) {
            if (task < NBH * NCH) p2_dc_task(a, lds, tid, lane, wave, task); else p2_gmlp_task(a, lds, tid, lane, wave, task - NBH * NCH); }
        SEAM(2);
    }
    if (IN(3)) { REP(3) p3_scan(a, lds, tid, bid, G); SEAM(3); }
    if (IN(4)) { REP(4) for (int task = bid; task < NBH * NCH; task += G) p4_out_task(a, lds, tid, lane, wave, task); SEAM(4); }
    if (IN(5)) { REP(5) {
        pg8::Gemm g{(const bf16*)(ws + WS_Y), (const bf16*)(ws + WS_WOT), T, DM, DM}; pg8::StaticOrder S; S.init(T, DM, G, bid);
        EpiX1 E{a.in[I_X], (bf16*)(ws + WS_XB1), (float*)(ws + WS_SSP)};
        pg8::gemm_phase<EpiX1, pg8::StaticOrder, true, true>(lds, g, S, E);
        }
        SEAM(5);
    }
    if (IN(6)) { REP(6) {
        pg8::Gemm g{(const bf16*)(ws + WS_XB1), (const bf16*)(ws + WS_WQT), T, 2048, DM}; pg8::StaticOrder S; S.init(T, 2048, G, bid);
        EpiQ E{(bf16*)(ws + WS_Q), 2048, (const float*)(ws + WS_SSP)};
        pg8::gemm_phase<EpiQ, pg8::StaticOrder, true, true>(lds, g, S, E); }
        SEAM(6);
    }
    if (IN(7)) { REP(7) p7_topk(a, lds, tid, lane, wave, bid, G); SEAM(7); }
    if (IN(8)) { REP(8) p8a_u(a, lds, lane, wave, bid, G); SEAM(8); }
    if (IN(9)) { p8m_coef(a, tid, bid, G); SEAM(9); }
    if (IN(10)) { p8b_v(a, lds, lane, wave, bid, G); }
#undef IN
#undef SEAM
}

extern "C" void kernel_launch(void* const* d_in, const int* in_sizes, int n_in, void* d_out, int out_size, void* d_ws, size_t ws_size, hipStream_t stream) {
    static int grid = 0;
    if (grid == 0) {
        if (n_in != 19 || in_sizes[0] != T * DM || out_size != T * DM || ws_size < WS_END) { fprintf(stderr, "kernel_launch: unexpected shapes (n_in %d, in0 %d, out %d, ws %zu); nothing launched\n", n_in, n_in > 0 ? in_sizes[0] : -1, out_size, ws_size); grid = -1; return; }
        int dev = 0, cus = 0;
        if (hipGetDevice(&dev) != hipSuccess || hipDeviceGetAttribute(&cus, hipDeviceAttributeMultiprocessorCount, dev) != hipSuccess) { grid = -1; return; }
        if (hipFuncSetAttribute((const void*)mk_fwd, hipFuncAttributeMaxDynamicSharedMemorySize, LDS_BYTES) != hipSuccess) { fprintf(stderr, "kernel_launch: hipFuncSetAttribute failed\n"); grid = -1; return; }
        (void)hipGetLastError();
        grid = cus;
    }
    if (grid < 0) return;
    (void)hipMemsetAsync((char*)d_ws + WS_CTL, 0, CTL_ZERO_BYTES, stream);
    Args a{};
    for (int i = 0; i < 19; ++i) a.in[i] = (const float*)d_in[i];
    a.out = (float*)d_out; a.ws = (unsigned char*)d_ws;
    if (N_LAUNCHES == 1) { a.ph_lo = 0; a.ph_hi = NPHASE; hipLaunchKernelGGL(mk_fwd, dim3(grid), dim3(NTHREADS), LDS_BYTES, stream, a); }
    else for (int p = 0; p < NPHASE; ++p) { a.ph_lo = p; a.ph_hi = p + 1; hipLaunchKernelGGL(mk_fwd, dim3(grid), dim3(NTHREADS), LDS_BYTES, stream, a); }
}
```

```cpp
#include <hip/hip_runtime.h>
#include <cstdio>
#include <cstdint>

#ifndef MK_N_LAUNCHES
#define MK_N_LAUNCHES 1
#endif

#define LAS __attribute__((address_space(3)))
#define GAS __attribute__((address_space(1)))
typedef unsigned short bf16;
typedef short bf16x8 __attribute__((ext_vector_type(8)));
typedef float f32x4 __attribute__((ext_vector_type(4)));
typedef float f32x2 __attribute__((ext_vector_type(2)));
typedef _Float16 f16x2 __attribute__((ext_vector_type(2)));
typedef unsigned u32x4 __attribute__((ext_vector_type(4)));
typedef unsigned u32x2 __attribute__((ext_vector_type(2)));

namespace pg8 {
typedef unsigned short bf16_t;
constexpr int BM = 256, BK = 64, HALF = 128, HTB = HALF * BK * 2, STAGE_BYTES = 8 * HTB, NXCD = 8, WGM = 8;
__host__ __device__ __forceinline__ int lds_byte(int r, int c) { const int st = (r >> 4) * 2 + (c >> 5), rr = r & 15, cc = c & 31, ob = rr * 64 + cc * 2; return st * 1024 + (ob ^ (((ob >> 9) & 1) << 5)); }
__host__ __device__ __forceinline__ void stage_rc(int b, int& R, int& C) { const int st = b / 1024, sb = b % 1024, swz = sb ^ (((sb >> 9) & 1) << 5); R = (st >> 1) * 16 + swz / 64; C = (st & 1) * 32 + (swz % 64) / 2; }
__host__ __device__ __forceinline__ int perm32(int rho) { const int n = rho >> 4, i = rho & 15; return 8 * (i >> 2) + 4 * n + (i & 3); }
struct Unit { int pm, pn; };
struct Gemm { const bf16_t* A; const bf16_t* Bt; int M, N, K; };
struct StaticOrder {
    int nM, nN, nwg, G, c;
    __host__ __device__ void init(int M, int N, int G_, int c_) { nM = M / BM; nN = N / BM; nwg = nM * nN; G = G_; c = c_; }
    __host__ __device__ bool next(int i, Unit& u) const {
        const long L = (long)i * G + c; if (L >= nwg) return false;
        int wgid = (int)L; { const int q = nwg / NXCD, r = nwg % NXCD, xcd = wgid % NXCD, off = wgid / NXCD; wgid = (xcd < r ? xcd * (q + 1) : r * (q + 1) + (xcd - r) * q) + off; }
        const int nig = WGM * nN, gid = wgid / nig, fm = gid * WGM, gsz = (nM - fm) < WGM ? (nM - fm) : WGM;
        u.pm = fm + ((wgid % nig) % gsz); u.pn = (wgid % nig) / gsz; return true;
    }
    __device__ __forceinline__ void a_ready(const Unit&) const {}
    __device__ __forceinline__ void done(const Unit&) const {}
};
struct XcdOrder {
    int nN, nrow, xi, nx, rank, nloc;
    __host__ __device__ void init(int M, int N, int xi_, int nx_, int rank_, int nloc_) { nN = N / BM; xi = xi_; nx = nx_; rank = rank_; nloc = nloc_; const int nM = M / BM; nrow = xi < nM ? (nM - xi + nx - 1) / nx : 0; }
    __host__ __device__ bool next(int i, Unit& u) const { const int idx = rank + i * nloc; if (idx >= nrow * nN) return false; u.pm = xi + nx * (idx % nrow); u.pn = idx / nrow; return true; }
    __device__ __forceinline__ void a_ready(const Unit&) const {}
    __device__ __forceinline__ void done(const Unit&) const {}
};
struct Z1Order {
    int xi, nx, rank, nloc, npair, rb;
    __host__ __device__ void init(int rb_, int npairs_total, int xi_, int nx_, int rank_, int nloc_) { rb = rb_; xi = xi_; nx = nx_; rank = rank_; nloc = nloc_; npair = xi < npairs_total ? (npairs_total - xi + nx - 1) / nx : 0; }
    __host__ __device__ bool next(int i, Unit& u) const { const int per = rb * 6, idx = rank + i * nloc; if (idx >= npair * per) return false;
        const int pr = xi + nx * (idx / per), w = idx % per, r8 = w & 7, ci = (w >> 3) % 6, hf = w / 48, par = pr & 1;
        u.pm = rb * (pr >> 1) + 8 * hf + r8; u.pn = ci < 4 ? par + 2 * ci : 8 + par + 2 * (ci - 4); return true; }
    __device__ __forceinline__ void a_ready(const Unit&) const {}
    __device__ __forceinline__ void done(const Unit&) const {}
};
typedef __bf16 bf16x2_t __attribute__((ext_vector_type(2)));
__device__ __forceinline__ unsigned cvt_pk_bf16(float lo, float hi) { const f32x2 v = {lo, hi}; const bf16x2_t b = __builtin_convertvector(v, bf16x2_t); return __builtin_bit_cast(unsigned, b); }

template <class Epi, class Sched, bool ALIGN_EPI = false, bool SP2 = false>
__device__ __forceinline__ void gemm_phase(LAS unsigned char* lds, const Gemm g, const Sched& S, const Epi& E) {
    const int tid = threadIdx.x, wid = __builtin_amdgcn_readfirstlane(tid >> 6), lane = tid & 63, wr = wid >> 2, wc = wid & 3, fr = lane & 15, fq = lane >> 4;
    const int K = g.K, nt = K / BK;
    unsigned voffA[2], voffB[2];
#pragma unroll
    for (int i = 0; i < 2; ++i) { int R, C; stage_rc(tid * 16 + i * 8192, R, C); const int Rb = Epi::PERM ? ((R & ~31) + perm32(R & 31)) : R;
        voffA[i] = (unsigned)(R * K + C) * 2u; voffB[i] = (unsigned)(Rb * K + C) * 2u; }
    const size_t kstep = (size_t)(BK * 2);
    const size_t hstep = (size_t)HALF * K * 2;
    const size_t tstep = 2 * hstep;
    const unsigned ldsw = (unsigned)wid * 1024u;
    const int aoff = lds_byte(wr * 64 + fr, fq * 8), boff = lds_byte(wc * 32 + fr, fq * 8);
#define PG8_SA(b, h) (((b) * 2 + (h)) * HTB)
#define PG8_SB(b, h) ((4 + (b) * 2 + (h)) * HTB)
#define PG8_STAGE(bufoff, gbase, voff) do { _Pragma("unroll") for (int _i = 0; _i < 2; ++_i) \
        __builtin_amdgcn_global_load_lds((const unsigned*)((const char*)(gbase) + (voff)[_i]), (LAS unsigned*)(lds + (bufoff) + ldsw + _i * 8192), 16, 0, 0); } while (0)
#define PG8_LDA(dst, b, h) do { _Pragma("unroll") for (int m = 0; m < 4; ++m) _Pragma("unroll") for (int k = 0; k < 2; ++k) dst[m][k] = *(const LAS bf16x8*)(lds + PG8_SA(b, h) + aoff + m * 2048 + k * 1024); } while (0)
#define PG8_LDB(dst, b, h) do { _Pragma("unroll") for (int n = 0; n < 2; ++n) _Pragma("unroll") for (int k = 0; k < 2; ++k) dst[n][k] = *(const LAS bf16x8*)(lds + PG8_SB(b, h) + boff + n * 2048 + k * 1024); } while (0)
#define PG8_MMA(ai, bj, At, Bt) do { __builtin_amdgcn_s_setprio(1); _Pragma("unroll") for (int m = 0; m < 4; ++m) _Pragma("unroll") for (int n = 0; n < 2; ++n) _Pragma("unroll") for (int k = 0; k < 2; ++k) \
        acc[ai][bj][m][n] = __builtin_amdgcn_mfma_f32_16x16x32_bf16(Bt[n][k], At[m][k], acc[ai][bj][m][n], 0, 0, 0); __builtin_amdgcn_s_setprio(0); } while (0)
#define PG8_WAIT_V(n) asm volatile("s_waitcnt vmcnt(" #n ")" ::: "memory")
#define PG8_WAIT_L(n) asm volatile("s_waitcnt lgkmcnt(" #n ")" ::: "memory")
#define PG8_BAR __builtin_amdgcn_s_barrier()
#define PG8_SCHED __builtin_amdgcn_sched_barrier(0)
    Unit cur, nxt; int ui = 0;
    if (!S.next(0, cur)) return;
    f32x4 acc[2][2][4][2];
#pragma unroll
    for (int a = 0; a < 2; ++a)
#pragma unroll
        for (int b = 0; b < 2; ++b)
#pragma unroll
            for (int m = 0; m < 4; ++m)
#pragma unroll
                for (int n = 0; n < 2; ++n) acc[a][b][m][n] = (f32x4){0.f, 0.f, 0.f, 0.f};
    bf16x8 At[4][2], B0[2][2], B1[2][2];
    const char* cA = (const char*)g.A + (size_t)cur.pm * tstep; const char* cB = (const char*)g.Bt + (size_t)cur.pn * tstep;
    S.a_ready(cur);
    if constexpr (SP2) {
        PG8_STAGE(PG8_SB(0, 0), cB, voffB); PG8_STAGE(PG8_SB(0, 1), cB + hstep, voffB); PG8_STAGE(PG8_SA(0, 0), cA, voffA); PG8_STAGE(PG8_SA(0, 1), cA + hstep, voffA);
        if (wr == 1) PG8_BAR;
        PG8_WAIT_V(2); PG8_BAR;
        PG8_STAGE(PG8_SB(1, 0), cB + kstep, voffB); PG8_STAGE(PG8_SA(1, 0), cA + kstep, voffA); PG8_STAGE(PG8_SB(1, 1), cB + hstep + kstep, voffB);
        PG8_WAIT_V(6); PG8_BAR;
    } else {
        PG8_STAGE(PG8_SB(0, 0), cB, voffB); PG8_STAGE(PG8_SA(0, 0), cA, voffA); PG8_STAGE(PG8_SB(0, 1), cB + hstep, voffB); PG8_STAGE(PG8_SA(0, 1), cA + hstep, voffA);
        if (wr == 1) PG8_BAR;
        PG8_WAIT_V(4); PG8_BAR;
        PG8_STAGE(PG8_SB(1, 0), cB + kstep, voffB); PG8_STAGE(PG8_SA(1, 0), cA + kstep, voffA); PG8_STAGE(PG8_SB(1, 1), cB + hstep + kstep, voffB);
        PG8_WAIT_V(6); PG8_BAR;
    }
    for (;;) {
        const bool has_next = S.next(ui + 1, nxt);
        const char* nA = has_next ? (const char*)g.A + (size_t)nxt.pm * tstep : cA; const char* nB = has_next ? (const char*)g.Bt + (size_t)nxt.pn * tstep : cB;
        for (int t = 0; t < nt; t += 2) {
            const bool last = (t == nt - 2);
            const char* a1 = cA + (size_t)(t + 1) * kstep;
            const char* a2 = last ? nA : cA + (size_t)(t + 2) * kstep; const char* b2 = last ? nB : cB + (size_t)(t + 2) * kstep;
            const char* a3 = a2 + kstep; const char* b3 = b2 + kstep;
            if (last && has_next) S.a_ready(nxt);
            if constexpr (SP2) {
            PG8_LDB(B0, 0, 0); PG8_LDB(B1, 0, 1); PG8_SCHED; PG8_LDA(At, 0, 0); PG8_STAGE(PG8_SA(1, 1), a1 + hstep, voffA);
            PG8_WAIT_V(8); PG8_WAIT_L(0); PG8_BAR; PG8_MMA(0, 0, At, B0); PG8_MMA(0, 1, At, B1); PG8_BAR; PG8_SCHED;
            PG8_LDA(At, 0, 1); PG8_STAGE(PG8_SB(0, 0), b2, voffB); PG8_STAGE(PG8_SB(0, 1), b2 + hstep, voffB); PG8_STAGE(PG8_SA(0, 0), a2, voffA);
            PG8_WAIT_V(8); PG8_WAIT_L(0); PG8_BAR; PG8_MMA(1, 0, At, B0); PG8_MMA(1, 1, At, B1); PG8_BAR; PG8_SCHED;
            PG8_LDB(B0, 1, 0); PG8_LDB(B1, 1, 1); PG8_SCHED; PG8_LDA(At, 1, 0); PG8_STAGE(PG8_SA(0, 1), a2 + hstep, voffA);
            PG8_WAIT_V(8); PG8_WAIT_L(0); PG8_BAR; PG8_MMA(0, 0, At, B0); PG8_MMA(0, 1, At, B1); PG8_BAR; PG8_SCHED;
            PG8_LDA(At, 1, 1); PG8_STAGE(PG8_SB(1, 0), b3, voffB); PG8_STAGE(PG8_SB(1, 1), b3 + hstep, voffB); PG8_STAGE(PG8_SA(1, 0), a3, voffA);
            PG8_WAIT_V(8); PG8_WAIT_L(0); PG8_BAR; PG8_MMA(1, 0, At, B0); PG8_MMA(1, 1, At, B1); PG8_BAR; PG8_SCHED;
            } else {
            PG8_LDB(B0, 0, 0); PG8_SCHED; PG8_LDA(At, 0, 0); PG8_STAGE(PG8_SA(1, 1), a1 + hstep, voffA);
            PG8_WAIT_L(8); PG8_BAR; PG8_WAIT_L(0); PG8_MMA(0, 0, At, B0); PG8_BAR; PG8_SCHED;
            PG8_LDB(B1, 0, 1); PG8_STAGE(PG8_SB(0, 0), b2, voffB);
            PG8_BAR; PG8_WAIT_L(0); PG8_MMA(0, 1, At, B1); PG8_BAR;
            PG8_LDA(At, 0, 1); PG8_STAGE(PG8_SA(0, 0), a2, voffA);
            PG8_BAR; PG8_WAIT_L(0); PG8_MMA(1, 0, At, B0); PG8_BAR; PG8_SCHED;
            PG8_STAGE(PG8_SB(0, 1), b2 + hstep, voffB);
            PG8_WAIT_V(6); PG8_BAR; PG8_MMA(1, 1, At, B1); PG8_BAR;
            PG8_LDB(B0, 1, 0); PG8_SCHED; PG8_LDA(At, 1, 0); PG8_STAGE(PG8_SA(0, 1), a2 + hstep, voffA);
            PG8_WAIT_L(8); PG8_BAR; PG8_WAIT_L(0); PG8_MMA(0, 0, At, B0); PG8_BAR; PG8_SCHED;
            PG8_LDB(B1, 1, 1); PG8_STAGE(PG8_SB(1, 0), b3, voffB);
            PG8_BAR; PG8_WAIT_L(0); PG8_MMA(0, 1, At, B1); PG8_BAR;
            PG8_LDA(At, 1, 1); PG8_STAGE(PG8_SA(1, 0), a3, voffA);
            PG8_BAR; PG8_WAIT_L(0); PG8_MMA(1, 0, At, B0); PG8_BAR; PG8_SCHED;
            PG8_STAGE(PG8_SB(1, 1), b3 + hstep, voffB);
            PG8_WAIT_V(6); PG8_BAR; PG8_MMA(1, 1, At, B1); PG8_BAR;
            }
        }
        if constexpr (ALIGN_EPI) { if (wr == 0) PG8_BAR; }
        E(acc, cur, wr, wc, fr, fq);
        if (!has_next) break;
#pragma unroll
        for (int a = 0; a < 2; ++a)
#pragma unroll
            for (int b = 0; b < 2; ++b)
#pragma unroll
                for (int m = 0; m < 4; ++m)
#pragma unroll
                    for (int n = 0; n < 2; ++n) acc[a][b][m][n] = (f32x4){0.f, 0.f, 0.f, 0.f};
        cur = nxt; cA = nA; cB = nB; ++ui;
        if constexpr (ALIGN_EPI) { if (wr == 1) PG8_BAR; }
    }
    PG8_WAIT_V(0);
    if constexpr (!ALIGN_EPI) { if (wr == 0) PG8_BAR; }
    PG8_BAR;
#undef PG8_SA
#undef PG8_SB
#undef PG8_STAGE
#undef PG8_LDA
#undef PG8_LDB
#undef PG8_MMA
#undef PG8_WAIT_V
#undef PG8_WAIT_L
#undef PG8_BAR
#undef PG8_SCHED
}
}

constexpr int NWAVES = 8, NTHREADS = 512;
constexpr int BATCH = 4, SEQ = 4096, DM = 1024, T = BATCH * SEQ;
constexpr int NH = 4, DH = 128, MW = 512, NIN = 3080, NZ = 3072, NBH = BATCH * NH, NCH = SEQ / 64;
constexpr int PH = 8, PKEYS = 128, PQD = 256, TOPK = 16, NEXP = 16384;
constexpr float EPS = 1e-6f;
constexpr int NPHASE = 10;
constexpr int NSL = 4;
constexpr int N_LAUNCHES = MK_N_LAUNCHES;

constexpr size_t MiB = 1u << 20;
constexpr size_t WS_CTL = 0, CTL_ZERO_BYTES = 65536;
constexpr size_t WS_SUMSQ2 = 128 * 1024;
constexpr size_t WS_RS1 = 1 * MiB;
constexpr size_t WS_LF = WS_RS1 + (size_t)T * 4;
constexpr size_t WS_IG = WS_LF + (size_t)NBH * SEQ * 4;
constexpr size_t WS_BC = WS_IG + (size_t)NBH * SEQ * 4;
constexpr size_t WS_AV = WS_BC + (size_t)NBH * SEQ * 4;
constexpr size_t WS_BL = WS_AV + (size_t)NBH * SEQ * 4;
constexpr size_t WS_AM = WS_BL + (size_t)NBH * NCH * 4;
constexpr size_t WS_DN = WS_AM + (size_t)NBH * NCH * 4;
constexpr size_t WS_NP = WS_DN + (size_t)NBH * NCH * DH * 4;
constexpr size_t WS_SU = WS_NP + (size_t)NBH * NCH * DH * 4;
constexpr size_t WS_SV = WS_SU + (size_t)NEXP * 4;
constexpr size_t WS_SMALL_END = WS_SV + (size_t)NEXP * 4;
constexpr size_t WS_W1T = 4 * MiB, WS_WOT = 10 * MiB, WS_WQT = 12 * MiB, WS_SKB = 16 * MiB;
constexpr size_t WS_XB = 17 * MiB, WS_XB1 = WS_XB;
constexpr size_t WS_Y = 49 * MiB;
constexpr size_t WS_Z = 81 * MiB;
constexpr size_t WS_Q = WS_Z, WS_IDX = WS_Z + 64 * MiB, WS_GATE = WS_Z + 72 * MiB;
constexpr size_t WS_DC = 177 * MiB, WS_UB = WS_DC;
constexpr size_t WS_CP = 209 * MiB, WS_VB = WS_CP;
constexpr size_t WS_SSP = 241 * MiB;
constexpr size_t WS_SSP2 = 242 * MiB;
constexpr size_t WS_COEF = WS_Z + 80 * MiB, WS_COEF_OS = WS_COEF + 7 * MiB;
constexpr size_t WS_APART = WS_DC + 8 * MiB;
constexpr size_t WS_END = 243 * MiB;
static_assert(WS_SMALL_END <= WS_W1T && WS_SKB + 512 * 1024 <= WS_XB, "ws map");
constexpr int CW_TMO = 0, CW_CODE = 1, CW_BAR = 4096;

constexpr int LDS_BYTES = 147456, LDSCTL_OFF = LDS_BYTES - 256;

typedef GAS unsigned gu32;
#define RLX_AGENT __ATOMIC_RELAXED, __HIP_MEMORY_SCOPE_AGENT
#define LDS_WAIT() asm volatile("s_waitcnt lgkmcnt(0)" ::: "memory")
__device__ __forceinline__ unsigned pk2(float lo, float hi) { return pg8::cvt_pk_bf16(lo, hi); }
__device__ __forceinline__ float bf2f(unsigned short b) { return __uint_as_float((unsigned)b << 16); }
__device__ __forceinline__ float bflo(unsigned w) { return __uint_as_float(w << 16); }
__device__ __forceinline__ float bfhi(unsigned w) { return __uint_as_float(w & 0xffff0000u); }
__device__ __forceinline__ float wave_sum(float v) {
#pragma unroll
    for (int o = 1; o < 64; o <<= 1) v += __shfl_xor(v, o);
    return v;
}
__device__ __forceinline__ float wave_max(float v) {
#pragma unroll
    for (int o = 1; o < 64; o <<= 1) v = fmaxf(v, __shfl_xor(v, o));
    return v;
}
__device__ __forceinline__ float sigmoidf_(float x) { return __builtin_amdgcn_rcpf(1.f + __expf(-x)); }
__device__ __forceinline__ float siluf_(float x) { return x * sigmoidf_(x); }
__device__ __forceinline__ float gelu_tanh(float x) { const float u = 1.5957691216057308f * (x + 0.044715f * x * x * x); return x * sigmoidf_(u); }

#define XB_TMO      128
#define XB_XCNT(j)  (256  + 64 * (j))
#define XB_XSUB(j)  (1280 + 64 * (j))
#define XB_XGEN(j)  (2304 + 64 * (j))
#define XB_TOP      3328
#define XB_TOPGEN   3392
#define XCD_BAR_WORDS 3456
#define XB_SPIN_CAP (1u << 18)
__device__ __forceinline__ unsigned xb_ld(unsigned* p)              { return __hip_atomic_load(p, __ATOMIC_RELAXED, __HIP_MEMORY_SCOPE_AGENT); }
__device__ __forceinline__ unsigned xb_add(unsigned* p, unsigned v) { return __hip_atomic_fetch_add(p, v, __ATOMIC_RELAXED, __HIP_MEMORY_SCOPE_AGENT); }
__device__ __forceinline__ unsigned xb_xcc_id() { return (unsigned)__builtin_amdgcn_s_getreg((3 << 11) | 20) & 0xFu; }
#define XB_SPIN(cond, bar) do { unsigned _sp = 0; while (cond) { __builtin_amdgcn_s_sleep(6); \
    if ((++_sp & 255u) == 0u) { if (xb_ld(&(bar)[XB_TMO])) break; if (_sp > XB_SPIN_CAP) { atomicAdd(&(bar)[XB_TMO], 1u); break; } } } } while (0)
struct XcdBarrier { unsigned* bar; unsigned x; volatile LAS unsigned* st; };
__device__ __forceinline__ XcdBarrier xcd_barrier_post(unsigned* bar, volatile LAS unsigned* st) {
    XcdBarrier b; b.bar = bar; b.x = xb_xcc_id(); b.st = st;
    if (threadIdx.x == 0) st[3] = xb_add(&bar[XB_XCNT(b.x)], 1u);
    return b;
}
__device__ __forceinline__ void xcd_barrier_complete(unsigned* bar, unsigned x, unsigned& nloc, unsigned& nx, unsigned& xi, unsigned& m8) {
    const unsigned G = gridDim.x * gridDim.y * gridDim.z;
    unsigned sum, cnt, mine, below, odd, sp = 0u;
    for (;;) {
        sum = 0u; cnt = 0u; mine = 0u; below = 0u; odd = 0u;
#pragma unroll
        for (unsigned j = 0; j < 16; ++j) { const unsigned c = xb_ld(&bar[XB_XCNT(j)]); sum += c; cnt += (c > 0u) ? 1u : 0u; mine = (j == x) ? c : mine; below += (c > 0u && j < x) ? 1u : 0u; odd |= (c & 7u); }
        if (sum == G) break;
        __builtin_amdgcn_s_sleep(1);
        if ((++sp & 255u) == 0u) { if (xb_ld(&bar[XB_TMO])) break; if (sp > XB_SPIN_CAP) { atomicAdd(&bar[XB_TMO], 1u); break; } }
    }
    nloc = mine > 0u ? mine : 1u; nx = cnt > 0u ? cnt : 1u; xi = below; m8 = odd == 0u ? 1u : 0u;
}
__device__ __forceinline__ void xcd_barrier(const XcdBarrier& b) {
    asm volatile("s_waitcnt vmcnt(0)" ::: "memory");
    __syncthreads();
    if (threadIdx.x == 0) {
        unsigned* bar = b.bar;
        __builtin_amdgcn_s_waitcnt(0);
        unsigned nloc = b.st[0], nx = b.st[1];
        if (nloc == 0u) { unsigned xi, m8; xcd_barrier_complete(bar, b.x, nloc, nx, xi, m8); b.st[0] = nloc; b.st[1] = nx; b.st[2] = xi; b.st[4] = m8; }
        const unsigned old = xb_add(&bar[XB_XSUB(b.x)], 1u);
        const unsigned gen = old / nloc;
        if (old + 1u == (gen + 1u) * nloc) {
            __builtin_amdgcn_fence(__ATOMIC_RELEASE, "agent");
            asm volatile("s_waitcnt vmcnt(0)" ::: "memory");
            const unsigned og = xb_add(&bar[XB_TOP], 1u);
            const unsigned tgt = (og / nx + 1u) * nx;
            if (og + 1u != tgt) XB_SPIN(xb_ld(&bar[XB_TOP]) < tgt, bar);
            (void)__hip_atomic_fetch_add(&bar[XB_XGEN(b.x)], 1u, __ATOMIC_RELAXED, __HIP_MEMORY_SCOPE_AGENT);
            __builtin_amdgcn_fence(__ATOMIC_ACQUIRE, "agent");
            asm volatile("s_waitcnt vmcnt(0)" ::: "memory");
        } else {
            XB_SPIN(xb_ld(&bar[XB_XGEN(b.x)]) == gen, bar);
            __builtin_amdgcn_fence(__ATOMIC_ACQUIRE, "agent");
            asm volatile("s_waitcnt vmcnt(0)" ::: "memory");
        }
    }
    __syncthreads();
}

struct XbTok { unsigned gen, tgt, lead; };
__device__ __forceinline__ XbTok xcd_arrive(const XcdBarrier& b) {
    asm volatile("s_waitcnt vmcnt(0)" ::: "memory");
    __syncthreads();
    XbTok k{0u, 0u, 0u};
    if (threadIdx.x == 0) {
        unsigned* bar = b.bar;
        __builtin_amdgcn_s_waitcnt(0);
        unsigned nloc = b.st[0], nx = b.st[1];
        if (nloc == 0u) { unsigned xi, m8; xcd_barrier_complete(bar, b.x, nloc, nx, xi, m8); b.st[0] = nloc; b.st[1] = nx; b.st[2] = xi; b.st[4] = m8; }
        const unsigned old = xb_add(&bar[XB_XSUB(b.x)], 1u);
        k.gen = old / nloc;
        if (old + 1u == (k.gen + 1u) * nloc) {
            __builtin_amdgcn_fence(__ATOMIC_RELEASE, "agent");
            asm volatile("s_waitcnt vmcnt(0)" ::: "memory");
            const unsigned og = xb_add(&bar[XB_TOP], 1u);
            k.tgt = (og / nx + 1u) * nx; k.lead = og + 1u != k.tgt ? 1u : 2u;
        }
    }
    return k;
}
__device__ __forceinline__ void xcd_wait(const XcdBarrier& b, const XbTok k) {
    asm volatile("s_waitcnt vmcnt(0)" ::: "memory");
    if (threadIdx.x == 0) {
        unsigned* bar = b.bar;
        if (k.lead) {
            if (k.lead == 1u) XB_SPIN(xb_ld(&bar[XB_TOP]) < k.tgt, bar);
            (void)__hip_atomic_fetch_add(&bar[XB_XGEN(b.x)], 1u, __ATOMIC_RELAXED, __HIP_MEMORY_SCOPE_AGENT);
        } else XB_SPIN(xb_ld(&bar[XB_XGEN(b.x)]) == k.gen, bar);
        __builtin_amdgcn_fence(__ATOMIC_ACQUIRE, "agent");
        asm volatile("s_waitcnt vmcnt(0)" ::: "memory");
    }
    __syncthreads();
}

#define XB_LARR(j)  (3520 + 64 * (j))
#define XB_LGEN(j)  (4544 + 64 * (j))
__device__ __forceinline__ void xcd_local_barrier(const XcdBarrier& b) {
    asm volatile("s_waitcnt vmcnt(0)" ::: "memory");
    __syncthreads();
    if (threadIdx.x == 0) {
        unsigned* bar = b.bar; const unsigned nloc = b.st[0];
        const unsigned old = xb_add(&bar[XB_LARR(b.x)], 1u), gen = old / nloc;
        if (old + 1u == (gen + 1u) * nloc) (void)__hip_atomic_fetch_add(&bar[XB_LGEN(b.x)], 1u, __ATOMIC_RELAXED, __HIP_MEMORY_SCOPE_AGENT);
        else XB_SPIN(xb_ld(&bar[XB_LGEN(b.x)]) == gen, bar);
        __builtin_amdgcn_fence(__ATOMIC_ACQUIRE, "agent");
        asm volatile("s_waitcnt vmcnt(0)" ::: "memory");
    }
    __syncthreads();
}

__device__ __forceinline__ unsigned xcd_local_arrive(const XcdBarrier& b) {
    asm volatile("s_waitcnt vmcnt(0)" ::: "memory");
    __syncthreads();
    unsigned gen = 0u;
    if (threadIdx.x == 0) {
        unsigned* bar = b.bar; const unsigned nloc = b.st[0];
        const unsigned old = xb_add(&bar[XB_LARR(b.x)], 1u); gen = old / nloc;
        if (old + 1u == (gen + 1u) * nloc) (void)__hip_atomic_fetch_add(&bar[XB_LGEN(b.x)], 1u, __ATOMIC_RELAXED, __HIP_MEMORY_SCOPE_AGENT);
    }
    return gen;
}
__device__ __forceinline__ void xcd_local_wait(const XcdBarrier& b, unsigned gen) {
    asm volatile("s_waitcnt vmcnt(0)" ::: "memory");
    if (threadIdx.x == 0) {
        unsigned* bar = b.bar;
        XB_SPIN(xb_ld(&bar[XB_LGEN(b.x)]) == gen, bar);
        __builtin_amdgcn_fence(__ATOMIC_ACQUIRE, "agent");
        asm volatile("s_waitcnt vmcnt(0)" ::: "memory");
    }
    __syncthreads();
}

__device__ __forceinline__ bf16x8 ldfrag(const LAS bf16* img, int ld, int i0, int k0, int lane) {
    return *(const LAS bf16x8*)(img + (i0 + (lane & 15)) * ld + k0 + 8 * (lane >> 4));
}
typedef short s16x4 __attribute__((ext_vector_type(4)));
__device__ __forceinline__ bf16x8 ldfragT(const LAS bf16* img, int ld, int i0, int k0, int lane) {
    const LAS bf16* p = img + (k0 + 8 * (lane >> 4) + ((lane & 15) >> 2)) * ld + i0 + 4 * (lane & 3);
    const s16x4 a = __builtin_amdgcn_ds_read_tr16_b64_v4i16((LAS s16x4*)p), b = __builtin_amdgcn_ds_read_tr16_b64_v4i16((LAS s16x4*)(p + 4 * ld));
    return (bf16x8){a[0], a[1], a[2], a[3], b[0], b[1], b[2], b[3]};
}
#define MMA16(nf, mf, acc) __builtin_amdgcn_mfma_f32_16x16x32_bf16(nf, mf, acc, 0, 0, 0)

__device__ __forceinline__ float row_rs2(const float* ssp, int r) {
    const f32x4* p = (const f32x4*)(ssp + (size_t)r * 16); const f32x4 a = p[0], b = p[1], c = p[2], d = p[3];
    const float s = (((a[0] + a[1]) + (a[2] + a[3])) + ((b[0] + b[1]) + (b[2] + b[3]))) + (((c[0] + c[1]) + (c[2] + c[3])) + ((d[0] + d[1]) + (d[2] + d[3])));
    return rsqrtf(s * (1.f / 1024.f) + 1e-6f);
}
template <int S2, int S1, int S0>
__device__ __forceinline__ void bfly16(float (&v)[16], int rank) {
    { const bool b = (rank >> 2) & 1;
#pragma unroll
      for (int j = 0; j < 8; ++j) { const float keep = b ? v[8 + j] : v[j], send = b ? v[j] : v[8 + j]; v[j] = keep + __shfl_xor(send, S2); } }
    { const bool b = (rank >> 1) & 1;
#pragma unroll
      for (int j = 0; j < 4; ++j) { const float keep = b ? v[4 + j] : v[j], send = b ? v[j] : v[4 + j]; v[j] = keep + __shfl_xor(send, S1); } }
    { const bool b = rank & 1;
#pragma unroll
      for (int j = 0; j < 2; ++j) { const float keep = b ? v[2 + j] : v[j], send = b ? v[j] : v[2 + j]; v[j] = keep + __shfl_xor(send, S0); } }
}
template <int S2, int S1, int S0>
__device__ __forceinline__ void bfly16i(int (&v)[16], int rank) {
    { const bool b = (rank >> 2) & 1;
#pragma unroll
      for (int j = 0; j < 8; ++j) { const int keep = b ? v[8 + j] : v[j], send = b ? v[j] : v[8 + j]; v[j] = keep + __shfl_xor(send, S2); } }
    { const bool b = (rank >> 1) & 1;
#pragma unroll
      for (int j = 0; j < 4; ++j) { const int keep = b ? v[4 + j] : v[j], send = b ? v[j] : v[4 + j]; v[j] = keep + __shfl_xor(send, S1); } }
    { const bool b = rank & 1;
#pragma unroll
      for (int j = 0; j < 2; ++j) { const int keep = b ? v[2 + j] : v[j], send = b ? v[j] : v[2 + j]; v[j] = keep + __shfl_xor(send, S0); } }
}
typedef pg8::Unit Unit;
struct EpiZ {
    static constexpr bool PERM = true;
    bf16* O; int ldc; const float* rs; int act_pn;
    __device__ __forceinline__ void operator()(const f32x4 (&acc)[2][2][4][2], const Unit& u, int wr, int wc, int fr, int fq) const {
        const int row0 = u.pm * 256 + wr * 64 + fr, col0 = u.pn * 256 + wc * 32 + 8 * fq; const bool act = u.pn >= act_pn;
#pragma unroll
        for (int ai = 0; ai < 2; ++ai)
#pragma unroll
            for (int m = 0; m < 4; ++m) { const int r = row0 + ai * 128 + m * 16; const float s = rs[r]; bf16* rowp = O + (size_t)r * ldc + col0;
#pragma unroll
                for (int bj = 0; bj < 2; ++bj) { f32x4 v0 = acc[ai][bj][m][0] * s, v1 = acc[ai][bj][m][1] * s;
                    if (act) {
#pragma unroll
                        for (int e = 0; e < 4; ++e) { v0[e] = gelu_tanh(v0[e]); v1[e] = gelu_tanh(v1[e]); } }
                    u32x4 w; w.x = pk2(v0[0], v0[1]); w.y = pk2(v0[2], v0[3]); w.z = pk2(v1[0], v1[1]); w.w = pk2(v1[2], v1[3]);
                    *(u32x4*)(rowp + bj * 128) = w; } }
    }
};
struct EpiQ {
    static constexpr bool PERM = true;
    bf16* O; int ldc; const float* sumsq; float* rs2out;
    __device__ __forceinline__ void operator()(const f32x4 (&acc)[2][2][4][2], const Unit& u, int wr, int wc, int fr, int fq) const {
        const int row0 = u.pm * 256 + wr * 64 + fr, col0 = u.pn * 256 + wc * 32 + 8 * fq;
#pragma unroll
        for (int ai = 0; ai < 2; ++ai)
#pragma unroll
            for (int m = 0; m < 4; ++m) { const int r = row0 + ai * 128 + m * 16; const float s = row_rs2(sumsq, r); bf16* rowp = O + (size_t)r * ldc + col0;
                if (u.pn == 0 && wc == 0 && fq == 0) rs2out[r] = s;
#pragma unroll
                for (int bj = 0; bj < 2; ++bj) { const f32x4 v0 = acc[ai][bj][m][0] * s, v1 = acc[ai][bj][m][1] * s;
                    u32x4 w; w.x = pk2(v0[0], v0[1]); w.y = pk2(v0[2], v0[3]); w.z = pk2(v1[0], v1[1]); w.w = pk2(v1[2], v1[3]);
                    *(u32x4*)(rowp + bj * 128) = w; } }
    }
};
struct EpiX1 {
    static constexpr bool PERM = true;
    const float* X; bf16* XB1; float* sumsq;
    __device__ __forceinline__ void operator()(const f32x4 (&acc)[2][2][4][2], const Unit& u, int wr, int wc, int fr, int fq) const {
        const int row0 = u.pm * 256 + wr * 64 + fr, col0 = u.pn * 256 + wc * 32 + 8 * fq;
#pragma unroll
        for (int ai = 0; ai < 2; ++ai)
#pragma unroll
            for (int m = 0; m < 4; ++m) { const int r = row0 + ai * 128 + m * 16; float ss = 0.f;
#pragma unroll
                for (int bj = 0; bj < 2; ++bj) { const size_t off = (size_t)r * DM + col0 + bj * 128;
                    const f32x4 xa = *(const f32x4*)(X + off), xb = *(const f32x4*)(X + off + 4);
                    const f32x4 v0 = acc[ai][bj][m][0] + xa, v1 = acc[ai][bj][m][1] + xb;
                    u32x4 w; w.x = pk2(v0[0], v0[1]); w.y = pk2(v0[2], v0[3]); w.z = pk2(v1[0], v1[1]); w.w = pk2(v1[2], v1[3]);
                    *(u32x4*)(XB1 + off) = w;
                    ss += (v0[0] * v0[0] + v0[1] * v0[1]) + (v0[2] * v0[2] + v0[3] * v0[3]) + (v1[0] * v1[0] + v1[1] * v1[1]) + (v1[2] * v1[2] + v1[3] * v1[3]); }
                ss += __shfl_xor(ss, 16); ss += __shfl_xor(ss, 32);
                if (fq == 0) sumsq[(size_t)r * 16 + u.pn * 4 + wc] = ss; }
    }
};

struct Args { const float* in[19]; float* out; unsigned char* ws; int ph_lo, ph_hi; };
enum { I_X = 0, I_G1, I_WIN, I_CW, I_CB, I_BI, I_BF, I_MNG, I_LNG, I_LNB, I_WS, I_BS, I_WOUT, I_G2, I_WQ, I_SK, I_PU, I_PV, I_GF };

__device__ __forceinline__ void transpose_item(const float* W, int ldsrc, int K, bf16* WT, const float* gk, LAS float* scr, int k0, int n0src, int n0dst, int lane) {
    float wv[32];
#pragma unroll
    for (int i = 0; i < 32; ++i) { const int kk = 2 * i + (lane >> 5); wv[i] = W[(size_t)(k0 + kk) * ldsrc + n0src + (lane & 31)]; }
    if (gk) {
#pragma unroll
        for (int i = 0; i < 32; ++i) wv[i] *= gk[k0 + 2 * i + (lane >> 5)]; }
#pragma unroll
    for (int i = 0; i < 32; ++i) { const int kk = 2 * i + (lane >> 5); scr[kk * 33 + (lane & 31)] = wv[i]; }
    LDS_WAIT(); asm volatile("" ::: "memory");
    const int c = lane & 7;
#pragma unroll
    for (int j = 0; j < 4; ++j) { const int n = (lane >> 3) + 8 * j; const LAS float* s = scr + (8 * c) * 33 + n;
        u32x4 o; o.x = pk2(s[0 * 33], s[1 * 33]); o.y = pk2(s[2 * 33], s[3 * 33]); o.z = pk2(s[4 * 33], s[5 * 33]); o.w = pk2(s[6 * 33], s[7 * 33]);
        *(u32x4*)(WT + (size_t)(n0dst + n) * K + k0 + 8 * c) = o; }
    LDS_WAIT(); asm volatile("" ::: "memory");
}
__device__ __forceinline__ float logsigmoidf_(float x) { return fminf(x, 0.f) - log1pf(__expf(-fabsf(x))); }

template <int PART>
__device__ __forceinline__ void p0_prologue(const Args& a, LAS unsigned char* lds, int tid, int lane, int wave, int bid, int G) {
    unsigned char* ws = a.ws;
    const float* win = a.in[I_WIN]; const float* g1 = a.in[I_G1];
    LAS bf16* WGB = (LAS bf16*)lds;
    if (PART != 1) { float wv[16], gv[16];
#pragma unroll
      for (int i = 0; i < 16; ++i) { const int idx = tid + NTHREADS * i, k = idx >> 3, c = idx & 7; wv[i] = win[(size_t)k * NIN + 2048 + c]; gv[i] = g1[k]; }
#pragma unroll
      for (int i = 0; i < 16; ++i) { const int idx = tid + NTHREADS * i, k = idx >> 3, c = idx & 7; WGB[c * 1032 + k] = (bf16)(pk2(wv[i] * gv[i], 0.f) & 0xffffu); }
      for (int i = tid; i < 8 * 1032 / 2; i += NTHREADS) ((LAS unsigned*)(WGB + 8 * 1032))[i] = 0u; }
    if (PART != 1) __syncthreads();
    if (wave >= 4 || PART == 1) {
        LAS float* scr = (LAS float*)(lds + 40960 + (PART == 1 ? wave : wave - 4) * 8448);
        constexpr int I1 = 16 * 96, I2 = 16 * 32, I3 = 16 * 64;
        const int tw = PART == 1 ? (wave < 4 ? bid * 4 + wave : G * 8 - 1 - (bid * 4 + (wave - 4))) : bid * 4 + (wave - 4), NTW = PART == 1 ? G * 8 : G * 4;
        const int it_lo = PART == 1 ? I1 : 0, it_hi = PART == 0 ? I1 : I1 + I2 + I3;
        for (int it = it_lo + tw; it < it_hi; it += NTW) {
            int r = it;
            if (r < I1) { const int kb = r / 96, nb = r % 96, n0 = 32 * nb; transpose_item(win, NIN, DM, (bf16*)(ws + WS_W1T), g1, scr, 64 * kb, n0 + (n0 >= 2048 ? 8 : 0), n0, lane); continue; } r -= I1;
            if (r < I2) { const int kb = r / 32, nb = r % 32; transpose_item(a.in[I_WOUT], DM, DM, (bf16*)(ws + WS_WOT), nullptr, scr, 64 * kb, 32 * nb, 32 * nb, lane); continue; } r -= I2;
            { const int kb = r / 64, nb = r % 64; transpose_item(a.in[I_WQ], 2048, DM, (bf16*)(ws + WS_WQT), a.in[I_G2], scr, 64 * kb, 32 * nb, 32 * nb, lane); }
        }
        if (PART != 0) { const f32x4* src = (const f32x4*)a.in[I_SK]; u32x2* dst = (u32x2*)(ws + WS_SKB);
          for (int i = tw * 64 + lane; i < PH * 2 * PKEYS * 128 / 4; i += NTW * 64) { const f32x4 v = src[i]; u32x2 o; o.x = pk2(v[0], v[1]); o.y = pk2(v[2], v[3]); dst[i] = o; } }
    } else if (PART != 1) {
        const float* x = a.in[I_X]; bf16* XB = (bf16*)(ws + WS_XB); float* rs1 = (float*)(ws + WS_RS1); float* LF = (float*)(ws + WS_LF); float* IG = (float*)(ws + WS_IG);
        const int fr = lane & 15, fq = lane >> 4;
        f32x4 bias = (f32x4){0.f, 0.f, 0.f, 0.f};
        if (fq == 0) bias = *(const f32x4*)a.in[I_BI]; else if (fq == 1) bias = *(const f32x4*)a.in[I_BF];
        for (int task = bid * 4 + wave; task < T / 16; task += G * 4) {
            const int m = 16 * task + fr; const float* xr = x + (size_t)m * DM + 8 * fq; bf16* xo = XB + (size_t)m * DM + 8 * fq;
            f32x4 acc = (f32x4){0.f, 0.f, 0.f, 0.f}; float ss = 0.f;
#pragma unroll 8
            for (int kk = 0; kk < 32; ++kk) {
                const f32x4 a0 = *(const f32x4*)(xr + 32 * kk), a1 = *(const f32x4*)(xr + 32 * kk + 4);
                ss += ((a0[0] * a0[0] + a0[1] * a0[1]) + (a0[2] * a0[2] + a0[3] * a0[3])) + ((a1[0] * a1[0] + a1[1] * a1[1]) + (a1[2] * a1[2] + a1[3] * a1[3]));
                u32x4 w; w.x = pk2(a0[0], a0[1]); w.y = pk2(a0[2], a0[3]); w.z = pk2(a1[0], a1[1]); w.w = pk2(a1[2], a1[3]);
                *(u32x4*)(xo + 32 * kk) = w;
                acc = MMA16(ldfrag(WGB, 1032, 0, 32 * kk, lane), __builtin_bit_cast(bf16x8, w), acc);
            }
            ss += __shfl_xor(ss, 16); ss += __shfl_xor(ss, 32);
            const float rs = rsqrtf(ss * (1.f / DM) + EPS);
            const int b = m >> 12, sq = m & (SEQ - 1);
            if (fq == 0) { rs1[m] = rs;
#pragma unroll
                for (int i = 0; i < 4; ++i) IG[(size_t)(b * NH + i) * SEQ + sq] = acc[i] * rs + bias[i]; }
            else if (fq == 1) {
#pragma unroll
                for (int i = 0; i < 4; ++i) LF[(size_t)(b * NH + i) * SEQ + sq] = logsigmoidf_(acc[i] * rs + bias[i]); }
        }
    }
}

__device__ __forceinline__ void p1_stats(const Args& a, int lane, int gw) {
    if (gw >= NBH * NCH) return;
    unsigned char* ws = a.ws; const int bh = gw >> 6, c = gw & 63; const size_t o = (size_t)bh * SEQ + c * 64 + lane;
    float b = ((const float*)(ws + WS_LF))[o];
#pragma unroll
    for (int d = 1; d < 64; d <<= 1) { const float t = __shfl_up(b, d); if (lane >= d) b += t; }
    const float av = ((const float*)(ws + WS_IG))[o] - b;
    ((float*)(ws + WS_BC))[o] = b; ((float*)(ws + WS_AV))[o] = av;
    const float bL = __shfl(b, 63), am = wave_max(av);
    if (lane == 0) { ((float*)(ws + WS_BL))[gw] = bL; ((float*)(ws + WS_AM))[gw] = am; }
}
__device__ __forceinline__ float m_scan_excl(const float* bL, const float* am, int bh, int lane) {
    float A = bL[bh * 64 + lane], B = am[bh * 64 + lane] + A;
#pragma unroll
    for (int d = 1; d < 64; d <<= 1) { const float Ap = __shfl_up(A, d), Bp = __shfl_up(B, d); if (lane >= d) { B = fmaxf(Bp + A, B); A = Ap + A; } }
    const float m = fmaxf(A, B);
    const float mp = __shfl_up(m, 1); return lane == 0 ? 0.f : mp;
}
__device__ __forceinline__ float m_prev_of(const float* bL, const float* am, int bh, int c) {
    return __shfl(m_scan_excl(bL, am, bh, (int)(threadIdx.x & 63)), c);
}

struct ConvIn { u32x4 x[5]; f32x4 w[8]; f32x4 b[2]; };
__device__ __forceinline__ void conv_load(ConvIn& C, const bf16* Z, const float* cw, const float* cb, int tok0, int sloc0, int r0, int ch0) {
#pragma unroll
    for (int j = 0; j < 4; ++j) { C.w[2 * j] = *(const f32x4*)(cw + j * 1024 + ch0); C.w[2 * j + 1] = *(const f32x4*)(cw + j * 1024 + ch0 + 4); }
    C.b[0] = *(const f32x4*)(cb + ch0); C.b[1] = *(const f32x4*)(cb + ch0 + 4);
#pragma unroll
    for (int i = 0; i < 5; ++i) { const int sr = r0 - 3 + i; const bool ok = sloc0 + sr >= 0; const u32x4 q = *(const u32x4*)(Z + (size_t)(tok0 + (ok ? sr : 0)) * NZ + ch0);
        C.x[i] = ok ? q : (u32x4){0u, 0u, 0u, 0u}; }
}
__device__ __forceinline__ void conv_compute(const ConvIn& C, float (&o)[2][8]) {
    float xv[5][8];
#pragma unroll
    for (int i = 0; i < 5; ++i) { const u32x4 q = C.x[i]; xv[i][0] = bflo(q.x); xv[i][1] = bfhi(q.x); xv[i][2] = bflo(q.y); xv[i][3] = bfhi(q.y); xv[i][4] = bflo(q.z); xv[i][5] = bfhi(q.z); xv[i][6] = bflo(q.w); xv[i][7] = bfhi(q.w); }
#pragma unroll
    for (int r = 0; r < 2; ++r)
#pragma unroll
        for (int e = 0; e < 8; ++e) { float acc = C.b[e >> 2][e & 3];
#pragma unroll
            for (int j = 0; j < 4; ++j) acc += C.w[2 * j + (e >> 2)][e & 3] * xv[r + j][e];
            o[r][e] = siluf_(acc); }
}

__device__ __forceinline__ void p2_dc_task(const Args& a, LAS unsigned char* lds, int tid, int lane, int wave, int task) {
    unsigned char* ws = a.ws; const bf16* Z = (const bf16*)(ws + WS_Z);
    const int bh = task >> 6, c = task & 63, b = bh >> 2, h = bh & 3, tok0 = b * SEQ + c * 64;
    const float* AV = (const float*)(ws + WS_AV) + (size_t)bh * SEQ + c * 64;
    const float mp = m_prev_of((const float*)(ws + WS_BL), (const float*)(ws + WS_AM), bh, c);
    const float M63 = fmaxf(mp, ((const float*)(ws + WS_AM))[bh * 64 + c]);
    LAS bf16* KT = (LAS bf16*)lds; LAS bf16* VT = (LAS bf16*)(lds + 17408); LAS float* WG = (LAS float*)(lds + 34816);
    if (tid < 64) WG[tid] = __expf(AV[tid] - M63);
    const int cc = tid & 15, rp = tid >> 4, r0 = 2 * rp;
    ConvIn ck; conv_load(ck, Z, a.in[I_CW], a.in[I_CB], tok0, c * 64, r0, 512 + h * DH + 8 * cc);
    u32x4 vq[2]; float avr[2];
#pragma unroll
    for (int r = 0; r < 2; ++r) { vq[r] = *(const u32x4*)(Z + (size_t)(tok0 + r0 + r) * NZ + 1024 + h * DH + 8 * cc); avr[r] = AV[r0 + r]; }
    { float o[2][8]; conv_compute(ck, o);
#pragma unroll
      for (int r = 0; r < 2; ++r) { LAS unsigned* d = (LAS unsigned*)(KT + (r0 + r) * 136 + 8 * cc);
#pragma unroll
          for (int e = 0; e < 4; ++e) d[e] = pk2(o[r][2 * e] * 0.08838834764831845f, o[r][2 * e + 1] * 0.08838834764831845f); } }
#pragma unroll
    for (int r = 0; r < 2; ++r) { const float wg = __expf(avr[r] - M63);
        const u32x4 q = vq[r];
        LAS unsigned* d = (LAS unsigned*)(VT + (r0 + r) * 136 + 8 * cc);
        d[0] = pk2(bflo(q.x) * wg, bfhi(q.x) * wg); d[1] = pk2(bflo(q.y) * wg, bfhi(q.y) * wg); d[2] = pk2(bflo(q.z) * wg, bfhi(q.z) * wg); d[3] = pk2(bflo(q.w) * wg, bfhi(q.w) * wg); }
    __syncthreads();
    f32x4 acc[8];
#pragma unroll
    for (int n = 0; n < 8; ++n) acc[n] = (f32x4){0.f, 0.f, 0.f, 0.f};
#pragma unroll
    for (int kk = 0; kk < 2; ++kk) { const bf16x8 mf = ldfragT(VT, 136, 16 * wave, 32 * kk, lane);
#pragma unroll
        for (int n = 0; n < 8; ++n) { const bf16x8 nf = ldfragT(KT, 136, 16 * n, 32 * kk, lane); acc[n] = MMA16(nf, mf, acc[n]); } }
    bf16* DC = (bf16*)(ws + WS_DC) + ((size_t)task * DH + 16 * wave + (lane & 15)) * DH + 4 * (lane >> 4);
#pragma unroll
    for (int n = 0; n < 8; ++n) { u32x2 o; o.x = pk2(acc[n][0], acc[n][1]); o.y = pk2(acc[n][2], acc[n][3]); *(u32x2*)(DC + 16 * n) = o; }
    if (tid < DH) { float s = 0.f;
#pragma unroll 8
        for (int r = 0; r < 64; ++r) s += WG[r] * bf2f(KT[r * 136 + tid]);
        ((float*)(ws + WS_DN))[(size_t)task * DH + tid] = s; }
    __syncthreads();
}

__device__ __forceinline__ void p2_gmlp_task(const Args& a, LAS unsigned char* lds, int tid, int lane, int wave, int task) {
    unsigned char* ws = a.ws; const bf16* Z = (const bf16*)(ws + WS_Z); bf16* Y = (bf16*)(ws + WS_Y);
    const int g = task & 3, ck = (task >> 2) & 31, b = task >> 7, tok0 = b * SEQ + ck * 128;
    LAS bf16* VV = (LAS bf16*)lds; LAS bf16* WM = (LAS bf16*)(lds + 34816);
    { const int r = tid >> 2, qd = tid & 3; const bf16* src = Z + (size_t)(tok0 + r) * NZ + 2560 + g * 128 + 32 * qd; float v[32];
#pragma unroll
      for (int i = 0; i < 4; ++i) { const u32x4 q = *(const u32x4*)(src + 8 * i);
          v[8 * i + 0] = bflo(q.x); v[8 * i + 1] = bfhi(q.x); v[8 * i + 2] = bflo(q.y); v[8 * i + 3] = bfhi(q.y); v[8 * i + 4] = bflo(q.z); v[8 * i + 5] = bfhi(q.z); v[8 * i + 6] = bflo(q.w); v[8 * i + 7] = bfhi(q.w); }
      float s = 0.f;
#pragma unroll
      for (int i = 0; i < 32; ++i) s += v[i];
      s += __shfl_xor(s, 1); s += __shfl_xor(s, 2);
      const float mu = s * (1.f / 128.f); float q2 = 0.f;
#pragma unroll
      for (int i = 0; i < 32; ++i) { v[i] -= mu; q2 += v[i] * v[i]; }
      q2 += __shfl_xor(q2, 1); q2 += __shfl_xor(q2, 2);
      const float rstd = rsqrtf(q2 * (1.f / 128.f) + EPS);
      const float* lg = a.in[I_LNG] + g * 128 + 32 * qd; const float* lb = a.in[I_LNB] + g * 128 + 32 * qd;
      LAS unsigned* d = (LAS unsigned*)(VV + r * 136 + 32 * qd);
#pragma unroll
      for (int i = 0; i < 16; ++i) d[i] = pk2(v[2 * i] * rstd * lg[2 * i] + lb[2 * i], v[2 * i + 1] * rstd * lg[2 * i + 1] + lb[2 * i + 1]); }
    { const f32x4* wsrc = (const f32x4*)(a.in[I_WS] + (size_t)g * 128 * 128);
#pragma unroll
      for (int i = 0; i < 8; ++i) { const int idx = tid + NTHREADS * i, t = idx >> 5, s4 = (idx & 31) * 4; f32x4 w = wsrc[idx];
          if ((t >> 6) < (s4 >> 6)) w = (f32x4){0.f, 0.f, 0.f, 0.f};
          u32x2 o; o.x = pk2(w[0], w[1]); o.y = pk2(w[2], w[3]); *(LAS u32x2*)(WM + t * 136 + s4) = o; } }
    __syncthreads();
    f32x4 acc[8];
#pragma unroll
    for (int n = 0; n < 8; ++n) acc[n] = (f32x4){0.f, 0.f, 0.f, 0.f};
#pragma unroll
    for (int kk = 0; kk < 4; ++kk) { const bf16x8 mf = ldfrag(WM, 136, 16 * wave, 32 * kk, lane);
#pragma unroll
        for (int n = 0; n < 8; ++n) { const bf16x8 nf = ldfragT(VV, 136, 16 * n, 32 * kk, lane); acc[n] = MMA16(nf, mf, acc[n]); } }
    const int t = 16 * wave + (lane & 15), d0 = 4 * (lane >> 4); const float bias = a.in[I_BS][g * 128 + t];
    const bf16* up = Z + (size_t)(tok0 + t) * NZ + 2048 + g * 128 + d0; bf16* yp = Y + (size_t)(tok0 + t) * DM + 512 + g * 128 + d0;
#pragma unroll
    for (int n = 0; n < 8; ++n) { const u32x2 uq = *(const u32x2*)(up + 16 * n);
        u32x2 o; o.x = pk2(bflo(uq.x) * (acc[n][0] + bias), bfhi(uq.x) * (acc[n][1] + bias)); o.y = pk2(bflo(uq.y) * (acc[n][2] + bias), bfhi(uq.y) * (acc[n][3] + bias));
        *(u32x2*)(yp + 16 * n) = o; }
    __syncthreads();
}

__device__ __forceinline__ void p3_scan(const Args& a, LAS unsigned char* lds, int tid, int rank, int nloc, int xi, int nx) {
    unsigned char* ws = a.ws; const float* bL = (const float*)(ws + WS_BL); const float* am = (const float*)(ws + WS_AM);
    const unsigned* DC = (const unsigned*)(ws + WS_DC); unsigned* CP = (unsigned*)(ws + WS_CP);
    LAS float* DEC = (LAS float*)lds;
    for (int i = tid; i < NBH * 64; i += NTHREADS) { const int bh = i >> 6, c = i & 63; const float mp = m_scan_excl(bL, am, bh, c); DEC[i] = __expf(mp - fmaxf(mp, am[i])); }
    __syncthreads();
    const int npair = xi < NBH / 2 ? (NBH / 2 - xi + nx - 1) / nx : 0, nseq = 2 * npair;
    for (int e2 = rank * NTHREADS + tid; e2 < nseq * (DH * DH / 2); e2 += nloc * NTHREADS) {
        const int ls = e2 >> 13, bh = 2 * (xi + nx * (ls >> 1)) + (ls & 1), el = e2 & 8191; float c0 = 0.f, c1 = 0.f;
#pragma unroll 16
        for (int c = 0; c < NCH; ++c) { const size_t o = ((size_t)(bh * NCH + c) << 13) + el;
            CP[o] = pk2(c0, c1); const unsigned d = DC[o]; const float dec = DEC[bh * 64 + c];
            c0 = dec * c0 + bflo(d); c1 = dec * c1 + bfhi(d); }
    }
    const float* DN = (const float*)(ws + WS_DN); float* NP = (float*)(ws + WS_NP);
    for (int e = rank * NTHREADS + tid; e < nseq * DH; e += nloc * NTHREADS) { const int ls = e >> 7, bh = 2 * (xi + nx * (ls >> 1)) + (ls & 1), k = e & 127; float n = 0.f;
#pragma unroll 8
        for (int c = 0; c < NCH; ++c) { const size_t o = (size_t)(bh * NCH + c) * DH + k; NP[o] = n; n = DEC[bh * 64 + c] * n + DN[o]; } }
    __syncthreads();
}

__device__ __forceinline__ void p4_out_task(const Args& a, LAS unsigned char* lds, int tid, int lane, int wave, int task) {
    unsigned char* ws = a.ws; const bf16* Z = (const bf16*)(ws + WS_Z); bf16* Y = (bf16*)(ws + WS_Y);
    const int bh = task >> 6, c = task & 63, b = bh >> 2, h = bh & 3, tok0 = b * SEQ + c * 64;
    LAS bf16* QS = (LAS bf16*)lds; LAS bf16* KS = (LAS bf16*)(lds + 17408); LAS bf16* VS = (LAS bf16*)(lds + 34816); LAS bf16* CS = (LAS bf16*)(lds + 54272);
    LAS bf16* PS = (LAS bf16*)(lds + 93440); LAS float* NUM = (LAS float*)(lds + 102656); LAS float* AS = (LAS float*)(lds + 139776); LAS float* MT = AS + 64; LAS float* BT = AS + 128;
    const float mp = m_prev_of((const float*)(ws + WS_BL), (const float*)(ws + WS_AM), bh, c);
    const int cc = tid & 15, rp = tid >> 4, r0 = 2 * rp;
    ConvIn cq, ck; conv_load(cq, Z, a.in[I_CW], a.in[I_CB], tok0, c * 64, r0, h * DH + 8 * cc); conv_load(ck, Z, a.in[I_CW], a.in[I_CB], tok0, c * 64, r0, 512 + h * DH + 8 * cc);
    u32x4 vq[2], cq4[4];
#pragma unroll
    for (int r = 0; r < 2; ++r) vq[r] = *(const u32x4*)(Z + (size_t)(tok0 + r0 + r) * NZ + 1024 + h * DH + 8 * cc);
    { const u32x4* src = (const u32x4*)((const bf16*)(ws + WS_CP) + (size_t)task * DH * DH);
#pragma unroll
      for (int i = 0; i < 4; ++i) cq4[i] = src[tid + NTHREADS * i]; }
    { float o[2][8]; conv_compute(cq, o);
#pragma unroll
      for (int r = 0; r < 2; ++r) { u32x4 w; w.x = pk2(o[r][0], o[r][1]); w.y = pk2(o[r][2], o[r][3]); w.z = pk2(o[r][4], o[r][5]); w.w = pk2(o[r][6], o[r][7]); *(LAS u32x4*)(QS + (r0 + r) * 136 + 8 * cc) = w; } }
    { float o[2][8]; conv_compute(ck, o); const float sc = 0.08838834764831845f;
#pragma unroll
      for (int r = 0; r < 2; ++r) { u32x4 w; w.x = pk2(o[r][0] * sc, o[r][1] * sc); w.y = pk2(o[r][2] * sc, o[r][3] * sc); w.z = pk2(o[r][4] * sc, o[r][5] * sc); w.w = pk2(o[r][6] * sc, o[r][7] * sc); *(LAS u32x4*)(KS + (r0 + r) * 136 + 8 * cc) = w; } }
#pragma unroll
    for (int r = 0; r < 2; ++r) { const u32x4 q = vq[r];
        LAS unsigned* d = (LAS unsigned*)(VS + (r0 + r) * 152 + 8 * cc); d[0] = q.x; d[1] = q.y; d[2] = q.z; d[3] = q.w; }
    if (tid < 64) { LAS unsigned* d = (LAS unsigned*)(VS + tid * 152 + 128); d[0] = 0x00003F80u;
#pragma unroll
        for (int e = 1; e < 8; ++e) d[e] = 0u; }
#pragma unroll
    for (int i = 0; i < 4; ++i) { const int idx = tid + NTHREADS * i, v = idx >> 4, kc = idx & 15; *(LAS u32x4*)(CS + v * 136 + 8 * kc) = cq4[i]; }
    if (tid < DH) CS[128 * 136 + tid] = (bf16)(pk2(((const float*)(ws + WS_NP))[(size_t)task * DH + tid], 0.f) & 0xffffu);
    for (int i = tid; i < 15 * 68; i += NTHREADS) ((LAS unsigned*)(CS + 129 * 136))[i] = 0u;
    if (tid < 64) { const size_t o = (size_t)bh * SEQ + c * 64 + tid; const float av = ((const float*)(ws + WS_AV))[o]; float pm = av;
#pragma unroll
        for (int d = 1; d < 64; d <<= 1) { const float t = __shfl_up(pm, d); if (lane >= d) pm = fmaxf(pm, t); }
        AS[tid] = av; MT[tid] = fmaxf(mp, pm); BT[tid] = ((const float*)(ws + WS_BC))[o]; }
    __syncthreads();
    const int fr = lane & 15, fq = lane >> 4, mt = wave & 3, hf = wave >> 2, t = 16 * mt + fr;
    {
        const float Mt = MT[t];
#pragma unroll
        for (int nn = 0; nn < 2; ++nn) { const int nt = 2 * hf + nn; f32x4 acc = (f32x4){0.f, 0.f, 0.f, 0.f};
#pragma unroll
            for (int kk = 0; kk < 4; ++kk) acc = MMA16(ldfrag(KS, 136, 16 * nt, 32 * kk, lane), ldfrag(QS, 136, 16 * mt, 32 * kk, lane), acc);
            float p[4];
#pragma unroll
            for (int i = 0; i < 4; ++i) { const int s = 16 * nt + 4 * fq + i; p[i] = (s <= t) ? acc[i] * __expf(AS[s] - Mt) : 0.f; }
            u32x2 o; o.x = pk2(p[0], p[1]); o.y = pk2(p[2], p[3]); *(LAS u32x2*)(PS + t * 72 + 16 * nt + 4 * fq) = o; }
    }
    __syncthreads();
    {
        const int n0 = hf ? 5 : 0, cnt = hf ? 4 : 5;
        f32x4 a1[5], a2[5];
#pragma unroll
        for (int nn = 0; nn < 5; ++nn) { a1[nn] = (f32x4){0.f, 0.f, 0.f, 0.f}; a2[nn] = (f32x4){0.f, 0.f, 0.f, 0.f}; }
#pragma unroll
        for (int kk = 0; kk < 2; ++kk) { const bf16x8 mf = ldfrag(PS, 72, 16 * mt, 32 * kk, lane);
#pragma unroll
            for (int nn = 0; nn < 5; ++nn) if (nn < cnt) a1[nn] = MMA16(ldfragT(VS, 152, 16 * (n0 + nn), 32 * kk, lane), mf, a1[nn]); }
#pragma unroll
        for (int kk = 0; kk < 4; ++kk) { const bf16x8 mf = ldfrag(QS, 136, 16 * mt, 32 * kk, lane);
#pragma unroll
            for (int nn = 0; nn < 5; ++nn) if (nn < cnt) a2[nn] = MMA16(ldfrag(CS, 136, 16 * (n0 + nn), 32 * kk, lane), mf, a2[nn]); }
        const float sc = __expf(mp - MT[t]);
#pragma unroll
        for (int nn = 0; nn < 5; ++nn) if (nn < cnt) {
#pragma unroll
            for (int i = 0; i < 4; ++i) NUM[t * 145 + 16 * (n0 + nn) + 4 * fq + i] = a1[nn][i] + sc * a2[nn][i]; }
    }
    __syncthreads();
    {
        const int rr = lane >> 3, cq = lane & 7, tt = 8 * wave + rr; const size_t tok = (size_t)(tok0 + tt);
        const u32x4 oa = *(const u32x4*)(Z + tok * NZ + 1536 + h * DH + 16 * cq), ob = *(const u32x4*)(Z + tok * NZ + 1536 + h * DH + 16 * cq + 8);
        const float* ng = a.in[I_MNG] + h * DH + 16 * cq; f32x4 ngv[4];
#pragma unroll
        for (int j = 0; j < 4; ++j) ngv[j] = ((const f32x4*)ng)[j];
        const float den = NUM[tt * 145 + 128]; const float inv = 1.f / fmaxf(fabsf(den), __expf(-(BT[tt] + MT[tt])));
        float hv[16]; float ss = 0.f;
#pragma unroll
        for (int i = 0; i < 16; ++i) { hv[i] = NUM[tt * 145 + 16 * cq + i] * inv; ss += hv[i] * hv[i]; }
        ss += __shfl_xor(ss, 1); ss += __shfl_xor(ss, 2); ss += __shfl_xor(ss, 4);
        const float r = rsqrtf(ss * (1.f / DH) + EPS);
        float ov[16];
#pragma unroll
        for (int w = 0; w < 4; ++w) { ov[2 * w] = bflo(oa[w]); ov[2 * w + 1] = bfhi(oa[w]); ov[8 + 2 * w] = bflo(ob[w]); ov[8 + 2 * w + 1] = bfhi(ob[w]); }
        float y[16];
#pragma unroll
        for (int i = 0; i < 16; ++i) y[i] = hv[i] * r * ngv[i >> 2][i & 3] * sigmoidf_(ov[i]);
        u32x4 w0, w1;
#pragma unroll
        for (int w = 0; w < 4; ++w) { w0[w] = pk2(y[2 * w], y[2 * w + 1]); w1[w] = pk2(y[8 + 2 * w], y[8 + 2 * w + 1]); }
        bf16* yp = Y + tok * DM + h * DH + 16 * cq; *(u32x4*)yp = w0; *(u32x4*)(yp + 8) = w1;
    }
    __syncthreads();
}

struct TabRow { f32x4 v[4]; };
typedef int i32x2_t __attribute__((ext_vector_type(2)));
__device__ __forceinline__ void tab_load(const Args& a, int row, int lane, TabRow& R) {
    const bool isv = row >= NEXP; const int e = row & (NEXP - 1);
    const f32x4* src = (const f32x4*)((isv ? a.in[I_PV] : a.in[I_PU]) + (size_t)e * DM) + (isv ? 64 * (lane >> 4) + (lane & 15) : lane);
    const int st = isv ? 16 : 64;
#pragma unroll
    for (int j = 0; j < 4; ++j) R.v[j] = src[j * st];
}
__device__ __forceinline__ unsigned i4x4(const f32x4 a, float inv) {
    unsigned r = 0u;
#pragma unroll
    for (int k = 0; k < 4; ++k) { const unsigned bits = __float_as_uint(__builtin_amdgcn_fmed3f(a[k] * inv, -8.f, 7.f) + 12582912.f); r |= (bits & 15u) << (4 * k); }
    return r;
}
__device__ __forceinline__ void tab_finish(const Args& a, int row, int lane, TabRow& R, LAS unsigned char* tsc, const f32x4 (&g2v)[4]) {
    unsigned char* ws = a.ws; const bool isv = row >= NEXP; const int e = row & (NEXP - 1); float am = 0.f, sq = 0.f;
#pragma unroll
    for (int j = 0; j < 4; ++j) { if (!isv) R.v[j] = R.v[j] * g2v[j]; am = fmaxf(am, fmaxf(fmaxf(fabsf(R.v[j][0]), fabsf(R.v[j][1])), fmaxf(fabsf(R.v[j][2]), fabsf(R.v[j][3]))));
        sq += (R.v[j][0] * R.v[j][0] + R.v[j][1] * R.v[j][1]) + (R.v[j][2] * R.v[j][2] + R.v[j][3] * R.v[j][3]); }
    am = wave_max(am);
    u32x2 o; float sc;
    if (isv) {
        sc = am > 0.f ? am * (1.f / 6.f) : 1.f; const float inv = 1.f / sc;
        unsigned r = 0u;
        r = __builtin_amdgcn_cvt_scalef32_pk_fp4_f32(r, R.v[0][0] * inv, R.v[0][1] * inv, 1.0f, 0); r = __builtin_amdgcn_cvt_scalef32_pk_fp4_f32(r, R.v[0][2] * inv, R.v[0][3] * inv, 1.0f, 1);
        r = __builtin_amdgcn_cvt_scalef32_pk_fp4_f32(r, R.v[1][0] * inv, R.v[1][1] * inv, 1.0f, 2); r = __builtin_amdgcn_cvt_scalef32_pk_fp4_f32(r, R.v[1][2] * inv, R.v[1][3] * inv, 1.0f, 3); o[0] = r; r = 0u;
        r = __builtin_amdgcn_cvt_scalef32_pk_fp4_f32(r, R.v[2][0] * inv, R.v[2][1] * inv, 1.0f, 0); r = __builtin_amdgcn_cvt_scalef32_pk_fp4_f32(r, R.v[2][2] * inv, R.v[2][3] * inv, 1.0f, 1);
        r = __builtin_amdgcn_cvt_scalef32_pk_fp4_f32(r, R.v[3][0] * inv, R.v[3][1] * inv, 1.0f, 2); r = __builtin_amdgcn_cvt_scalef32_pk_fp4_f32(r, R.v[3][2] * inv, R.v[3][3] * inv, 1.0f, 3); o[1] = r;
        *(LAS u32x2*)(tsc + 8 * lane) = o;
        const auto tr = __builtin_amdgcn_ds_read_tr4_b64_v2i32((LAS i32x2_t*)(tsc + 8 * lane));
        o[0] = (unsigned)tr[0]; o[1] = (unsigned)tr[1];
    } else {
        sq = wave_sum(sq); sc = fminf(am * (1.f / 7.f), 0.345f * sqrtf(sq * (1.f / DM))); sc = sc > 0.f ? sc : 1.f; const float inv = 1.f / sc;
#pragma unroll
        for (int j = 0; j < 4; ++j) *(unsigned short*)(ws + WS_UB + (size_t)j * (NEXP * 128) + (size_t)e * 128 + 2 * lane) = (unsigned short)i4x4(R.v[j], inv);
    }
    if (isv) *(u32x2*)(ws + WS_VB + (size_t)(lane >> 4) * (NEXP * 128) + (size_t)e * 128 + 8 * (lane & 15)) = o;
    if (lane == 0) ((_Float16*)(ws + WS_SU))[2 * e + (isv ? 1 : 0)] = (_Float16)sc;
}

template <int N> __device__ __forceinline__ void bitonic_sort_desc(float (&v)[N]) {
#pragma unroll
    for (int k = 2; k <= N; k <<= 1)
#pragma unroll
        for (int j = k >> 1; j > 0; j >>= 1)
#pragma unroll
            for (int i = 0; i < N; ++i) { const int l = i ^ j; if (l > i) { const float mx = fmaxf(v[i], v[l]), mn = fminf(v[i], v[l]); if ((i & k) == 0) { v[i] = mx; v[l] = mn; } else { v[i] = mn; v[l] = mx; } } }
}
__device__ __forceinline__ void merge_top16(float (&a)[16], const float (&b)[16]) {
#pragma unroll
    for (int i = 0; i < 16; ++i) a[i] = fmaxf(a[i], b[15 - i]);
#pragma unroll
    for (int j = 8; j > 0; j >>= 1)
#pragma unroll
        for (int i = 0; i < 16; ++i) { const int l = i ^ j; if (l > i) { const float mx = fmaxf(a[i], a[l]), mn = fminf(a[i], a[l]); a[i] = mx; a[l] = mn; } }
}
constexpr int P7_SK = 0, P7_QS = 69632, P7_LS = P7_QS + 64 * 264 * 2, P7_OS = P7_LS + 64 * 33 * 4, P7_OE = P7_OS + 64 * 16 * 4, P7_END = P7_OE + 64 * 16 * 4;
constexpr int P7_TS = P7_END;
static_assert(P7_TS + 4 * 512 <= LDSCTL_OFF, "P7 LDS map");
struct P7Map {
    int h, first, step, cnt, local, xi, nx;
    __device__ __forceinline__ int tile(int k) const { const int lt = first + k * step; return local ? (xi + nx * (lt >> 2)) * 4 + (lt & 3) : lt; }
};
__device__ __forceinline__ void p7_pre(const Args& a, LAS unsigned char* lds, int tid, int bid, int G, int h) {
    unsigned char* ws = a.ws;
    LAS bf16* SK = (LAS bf16*)(lds + P7_SK);
    { const u32x4* src = (const u32x4*)((const bf16*)(ws + WS_SKB) + (size_t)h * 2 * PKEYS * 128);
#pragma unroll
      for (int i = 0; i < 8; ++i) { const int idx = tid + NTHREADS * i, r = idx >> 4, cc = idx & 15; *(LAS u32x4*)(SK + r * 136 + 8 * cc) = src[idx]; } }
    { u32x4* apz = (u32x4*)(ws + WS_APART); const u32x4 ones = (u32x4){0xFFFFFFFFu, 0xFFFFFFFFu, 0xFFFFFFFFu, 0xFFFFFFFFu};
      for (int i = bid * NTHREADS + tid; i < NSL * T * 64 / 4; i += G * NTHREADS) apz[i] = ones;
      for (int i = bid * NTHREADS + tid; i < T * NSL; i += G * NTHREADS) ((unsigned*)(ws + WS_SSP2))[i] = 0xFFFFFFFFu; }
}
__device__ __forceinline__ void p7_topk(const Args& a, LAS unsigned char* lds, int tid, int lane, int wave, int bid, int G, const P7Map M, bool pre_done) {
    unsigned char* ws = a.ws; const bf16* Q = (const bf16*)(ws + WS_Q);
    const int h = M.h;
    if (!pre_done) p7_pre(a, lds, tid, bid, G, h);
    LAS bf16* SK = (LAS bf16*)(lds + P7_SK); LAS bf16* QS = (LAS bf16*)(lds + P7_QS); LAS float* LS = (LAS float*)(lds + P7_LS);
    const int fr = lane & 15, fq = lane >> 4, mt = wave & 3, p = wave >> 2;
    LAS unsigned char* tsc = lds + P7_TS + 512 * (wave & 3);
    f32x4 g2v[4];
#pragma unroll
    for (int j = 0; j < 4; ++j) g2v[j] = ((const f32x4*)a.in[I_G2])[64 * j + lane];
    constexpr int TCH = 8;
    const int tstride = TCH * G * 4; int it = 0;
    u32x4 qpre[4];
    if (M.cnt > 0) {
#pragma unroll
        for (int i = 0; i < 4; ++i) { const int idx = tid + NTHREADS * i, r = idx >> 5, cc = idx & 31; qpre[i] = *(const u32x4*)(Q + (size_t)(M.tile(0) * 64 + r) * 2048 + h * PQD + 8 * cc); } }
    for (int kt = 0; kt < M.cnt; ++kt, ++it) {
        const int tile = M.tile(kt), tokb = tile * 64;
#pragma unroll
        for (int i = 0; i < 4; ++i) { const int idx = tid + NTHREADS * i, r = idx >> 5, cc = idx & 31; *(LAS u32x4*)(QS + r * 264 + 8 * cc) = qpre[i]; }
        __syncthreads();
        if (kt + 1 < M.cnt) { const int tnx = M.tile(kt + 1);
#pragma unroll
            for (int i = 0; i < 4; ++i) { const int idx = tid + NTHREADS * i, r = idx >> 5, cc = idx & 31; qpre[i] = *(const u32x4*)(Q + (size_t)(tnx * 64 + r) * 2048 + h * PQD + 8 * cc); } }
        const int trow0 = (it * G + bid) * 4 + (wave - 4); TabRow tr0, tr1, tr2, tr3;
        const bool tdo = wave >= 4 && it < TCH;
        const int rc0 = min(trow0, 2 * NEXP - 1), rc1 = min(trow0 + tstride, 2 * NEXP - 1), rc2 = min(trow0 + 2 * tstride, 2 * NEXP - 1), rc3 = min(trow0 + 3 * tstride, 2 * NEXP - 1);
        if (tdo) { tab_load(a, rc0, lane, tr0); tab_load(a, rc1, lane, tr1); tab_load(a, rc2, lane, tr2); tab_load(a, rc3, lane, tr3); asm volatile("" ::: "memory"); }
        __builtin_amdgcn_sched_barrier(0);
        {
            f32x4 acc[8];
#pragma unroll
            for (int n = 0; n < 8; ++n) acc[n] = (f32x4){0.f, 0.f, 0.f, 0.f};
#pragma unroll
            for (int kk = 0; kk < 4; ++kk) { const bf16x8 mf = ldfrag(QS, 264, 16 * mt, 128 * p + 32 * kk, lane);
#pragma unroll
                for (int n = 0; n < 8; ++n) acc[n] = MMA16(ldfrag(SK + p * 128 * 136, 136, 16 * n, 32 * kk, lane), mf, acc[n]); }
            float v[32];
#pragma unroll
            for (int n = 0; n < 8; ++n)
#pragma unroll
                for (int i = 0; i < 4; ++i) v[4 * n + i] = __uint_as_float((__float_as_uint(acc[n][i]) & 0xffffff80u) | (unsigned)(16 * n + 4 * fq + i));
            bitonic_sort_desc<32>(v);
            float top[16], oth[16];
#pragma unroll
            for (int i = 0; i < 16; ++i) top[i] = v[i];
#pragma unroll
            for (int i = 0; i < 16; ++i) oth[i] = __shfl_xor(top[i], 16);
            merge_top16(top, oth);
#pragma unroll
            for (int i = 0; i < 16; ++i) oth[i] = __shfl_xor(top[i], 32);
            merge_top16(top, oth);
            if (fq == 0) {
#pragma unroll
                for (int i = 0; i < 16; ++i) LS[(16 * mt + fr) * 33 + p * 16 + i] = top[i]; }
        }
        __syncthreads();
        if (tdo) { if (trow0 < 2 * NEXP) tab_finish(a, rc0, lane, tr0, tsc, g2v); if (trow0 + tstride < 2 * NEXP) tab_finish(a, rc1, lane, tr1, tsc, g2v); if (trow0 + 2 * tstride < 2 * NEXP) tab_finish(a, rc2, lane, tr2, tsc, g2v);
                   if (trow0 + 3 * tstride < 2 * NEXP) tab_finish(a, rc3, lane, tr3, tsc, g2v); }
        if (wave < 4) {
            const int tl = 16 * wave + (lane >> 2), u = lane & 3;
            const LAS float* L1 = LS + tl * 33; const LAS float* L2 = L1 + 16; LAS float* OS = (LAS float*)(lds + P7_OS) + tl * 16; LAS int* OE = (LAS int*)(lds + P7_OE) + tl * 16;
            float s1v[4], hd[4], k2c[4]; int bpk = 0; const float s20 = L2[0];
#pragma unroll
            for (int j = 0; j < 4; ++j) { s1v[j] = L1[u + 4 * j]; k2c[j] = s20; hd[j] = s1v[j] + s20; }
#pragma unroll 1
            for (int r = 0; r < 16; ++r) {
                const float lm = fmaxf(fmaxf(hd[0], hd[1]), fmaxf(hd[2], hd[3]));
                const int jl = hd[0] == lm ? 0 : hd[1] == lm ? 1 : hd[2] == lm ? 2 : 3;
                float m = fmaxf(lm, __int_as_float(__builtin_amdgcn_mov_dpp(__float_as_int(lm), 0xB1, 0xf, 0xf, true)));
                m = fmaxf(m, __int_as_float(__builtin_amdgcn_mov_dpp(__float_as_int(m), 0x4E, 0xf, 0xf, true)));
                int f = (lm == m) ? u : 4; f = min(f, __builtin_amdgcn_mov_dpp(f, 0xB1, 0xf, 0xf, true)); f = min(f, __builtin_amdgcn_mov_dpp(f, 0x4E, 0xf, 0xf, true));
                if (f == u) {
                    const int b = (bpk >> (8 * jl)) & 255, nb = b + 1, av = u + 4 * jl;
                    const float k1 = jl == 0 ? s1v[0] : jl == 1 ? s1v[1] : jl == 2 ? s1v[2] : s1v[3], k2 = jl == 0 ? k2c[0] : jl == 1 ? k2c[1] : jl == 2 ? k2c[2] : k2c[3];
                    OS[r] = m; OE[r] = (int)(__float_as_uint(k1) & 127u) * PKEYS + (int)(__float_as_uint(k2) & 127u);
                    const bool ok = (av + 1) * (nb + 1) <= 16; const float k2n = L2[ok ? nb : 0]; const float nv = ok ? k1 + k2n : -INFINITY;
                    bpk += 1 << (8 * jl);
#pragma unroll
                    for (int j = 0; j < 4; ++j) { hd[j] = (j == jl) ? nv : hd[j]; k2c[j] = (j == jl) ? k2n : k2c[j]; }
                }
            }
            const f32x4 sv = *(const LAS f32x4*)(OS + 4 * u); const float mx = OS[0];
            f32x4 ev; float sum = 0.f;
#pragma unroll
            for (int i = 0; i < 4; ++i) { ev[i] = __expf(sv[i] - mx); sum += ev[i]; }
            sum += __int_as_float(__builtin_amdgcn_mov_dpp(__float_as_int(sum), 0xB1, 0xf, 0xf, true)); sum += __int_as_float(__builtin_amdgcn_mov_dpp(__float_as_int(sum), 0x4E, 0xf, 0xf, true));
            const float inv = 1.f / sum; const size_t o = (size_t)(tokb + tl) * 128 + h * 16 + 4 * u;
            *(u32x4*)((int*)(ws + WS_IDX) + o) = *(const LAS u32x4*)(OE + 4 * u);
            *(f32x4*)((float*)(ws + WS_GATE) + o) = ev * inv;
        }
    }
    if (wave >= 4) for (; it < TCH; ++it) { const int trow0 = (it * G + bid) * 4 + (wave - 4);
        for (int row = trow0; row < 2 * NEXP; row += tstride) { TabRow tr; tab_load(a, row, lane, tr); tab_finish(a, row, lane, tr, tsc, g2v); } }
    if (wave >= 4 && 4 * tstride < 2 * NEXP) for (int it2 = 0; it2 < TCH; ++it2)
        for (int row = (it2 * G + bid) * 4 + (wave - 4) + 4 * tstride; row < 2 * NEXP; row += tstride) { TabRow tr; tab_load(a, row, lane, tr); tab_finish(a, row, lane, tr, tsc, g2v); }
    __syncthreads();
}

struct Rows8 { u32x4 r[8]; };
template <int HB> __device__ __forceinline__ void issue8(Rows8& R, const unsigned char* ubase, unsigned loff, const u32x4 (&e)[4]) {
#pragma unroll
    for (int i = 0; i < 8; ++i) R.r[i] = *(const u32x4*)(ubase + (size_t)((e[2 * HB + (i >> 2)][i & 3] << 7) + loff));
}
template <int OFF> __device__ __forceinline__ void dot8(const Rows8& R, const unsigned (&xh)[4], const unsigned (&xl)[4], int (&d)[16]) {
#pragma unroll
    for (int i = 0; i < 8; ++i) { int s = 0;
#pragma unroll
        for (int w = 0; w < 4; ++w) s = __builtin_amdgcn_sdot8((int)R.r[i][w], (int)xh[w], s, false);
        s <<= 4;
#pragma unroll
        for (int w = 0; w < 4; ++w) s = __builtin_amdgcn_sdot8((int)R.r[i][w], (int)xl[w], s, false);
        d[OFF + i] = s; }
}
#ifndef U_NO_EXTRA
#define U_NO_EXTRA 3
#endif
#define P8_PIN __builtin_amdgcn_sched_barrier(0)
__device__ __forceinline__ void p8a_u(const Args& a, LAS unsigned char* lds, int lane, int wave, int bid, int G) {
    unsigned char* ws = a.ws; const int slice = bid & 3, half = (bid >> 2) & 1, wsl = (bid >> 3) * NWAVES + wave, nws = (G >> 3) * NWAVES, g = lane >> 3, q = lane & 7;
    const unsigned char* U4 = ws + WS_UB; const unsigned loff = slice * (NEXP * 128) + 16 * q; const bf16* XB1 = (const bf16*)(ws + WS_XB1) + 256 * slice + 32 * q + 4 * g; const unsigned* IDX = (const unsigned*)(ws + WS_IDX) + 16 * g;
    unsigned* AP = (unsigned*)(ws + WS_APART);
    LAS unsigned* XS = (LAS unsigned*)(lds + wave * 256);
    LAS unsigned* SL = (LAS unsigned*)(lds + 4096);
    { const u32x4* src = (const u32x4*)(ws + WS_SU); const int tid = wave * 64 + lane;
#pragma unroll
      for (int i = 0; i < NEXP / 4 / NTHREADS; ++i) *(LAS u32x4*)(SL + 4 * (tid + NTHREADS * i)) = src[tid + NTHREADS * i]; }
    __syncthreads();
    const int tend = (half + 1) * (T / 2);
    const int nb = G >> 3, jb = bid >> 3, ipb = (T / 2) / nb, NO = ipb / 8 + (ipb * U_NO_EXTRA) / 256;
    const int i0 = wave < 4 ? wave : 4 * NO + (wave - 4), cnt = wave < 4 ? NO : ipb / 4 - NO;
    auto tok = [&](int n) { const int i = i0 + 4 * n; return half * (T / 2) + 8 * jb + (i & 7) + 8 * nb * (i >> 3); };
    if (cnt <= 0) return;
    int t = tok(0);
    const int own_k = (slice - wsl) & 3;
    const float* GATEp = (const float*)(ws + WS_GATE) + 16 * g + 2 * q;
    const float* RS2 = (const float*)(ws + WS_RS1);
    unsigned char* C8 = ws + WS_COEF; float* OS = (float*)(ws + WS_COEF_OS);
    const int cidx = 96 * ((16 * g + 2 * q) >> 5) + 8 * ((16 * g + 2 * q) & 3) + (((16 * g + 2 * q) & 31) >> 2);
    u32x2 idcur = *(const u32x2*)((const unsigned*)(ws + WS_IDX) + (size_t)t * 128 + 2 * lane);
    int tN = -1, tO = -1; u32x2 eN = (u32x2){0u, 0u}; f32x2 gN = (f32x2){0.f, 0.f}, gO = gN; float suN[2] = {0.f, 0.f}, svN[2] = {0.f, 0.f}, rsN = 0.f, suO[2] = {0.f, 0.f}, svO[2] = {0.f, 0.f}, rsO = 0.f; unsigned pw[4] = {0u, 0u, 0u, 0u};
    auto stage_top = [&](int ph, int tcur, bool has) {
        if (ph == 0) { tO = tN; gO = gN; suO[0] = suN[0]; suO[1] = suN[1]; svO[0] = svN[0]; svO[1] = svN[1]; rsO = rsN; tN = -1;
            if (has) { tN = tcur; eN = idcur; gN = *(const f32x2*)(GATEp + (size_t)tcur * 128); } }
        else if (ph == 1 && tN >= 0) {
            { unsigned w0 = SL[eN[0]], w1 = SL[eN[1]]; asm volatile("" : "+v"(w0), "+v"(w1)); const f16x2 h0 = __builtin_bit_cast(f16x2, w0), h1 = __builtin_bit_cast(f16x2, w1);
              suN[0] = (float)h0[0]; svN[0] = (float)h0[1]; suN[1] = (float)h1[0]; svN[1] = (float)h1[1]; }
            rsN = RS2[tN]; }
        else if (ph == 2 && tO >= 0) {
#pragma unroll
            for (int sl = 0; sl < NSL; ++sl) pw[sl] = __hip_atomic_load(AP + ((size_t)sl * T + tO) * 64 + 8 * g + q, __ATOMIC_RELAXED, __HIP_MEMORY_SCOPE_AGENT); }
    };
    auto stage_end = [&](int ph) {
        if (ph == 0 && tN >= 0) { asm volatile("" : "+v"(eN[0]), "+v"(eN[1]), "+v"(gN[0]), "+v"(gN[1])); }
        else if (ph == 1 && tN >= 0) {
            suN[0] *= rsN; suN[1] *= rsN; asm volatile("" : "+v"(svN[0]), "+v"(svN[1])); }
        else if (ph == 2 && tO >= 0) {
            if (!__all(pw[0] != 0xFFFFFFFFu && pw[1] != 0xFFFFFFFFu && pw[2] != 0xFFFFFFFFu && pw[3] != 0xFFFFFFFFu)) {
                unsigned spins = 0; bool okv;
                do { __builtin_amdgcn_s_sleep(2);
#pragma unroll
                    for (int sl = 0; sl < NSL; ++sl) pw[sl] = __hip_atomic_load(AP + ((size_t)sl * T + tO) * 64 + 8 * g + q, __ATOMIC_RELAXED, __HIP_MEMORY_SCOPE_AGENT);
                    okv = __all(pw[0] != 0xFFFFFFFFu && pw[1] != 0xFFFFFFFFu && pw[2] != 0xFFFFFFFFu && pw[3] != 0xFFFFFFFFu);
                } while (!okv && ++spins < (1u << 20)); }
            float h0 = 0.f, h1 = 0.f;
#pragma unroll
            for (int sl = 0; sl < NSL; ++sl) { unsigned w = pw[sl]; asm volatile("" : "+v"(w)); const f16x2 hv = __builtin_bit_cast(f16x2, w); h0 += (float)hv[0]; h1 += (float)hv[1]; }
            const float c0 = gelu_tanh(suO[0] * h0) * gO[0] * svO[0], c1 = gelu_tanh(suO[1] * h1) * gO[1] * svO[1];
            const float cm = wave_max(fmaxf(fabsf(c0), fabsf(c1))), sc = cm > 0.f ? 240.f / cm : 1.f;
            float v0 = c0 * sc, v1 = c1 * sc;
            const int p0 = __builtin_amdgcn_cvt_pk_fp8_f32(v0, v1, 0, false); v0 -= __builtin_amdgcn_cvt_f32_fp8(p0, 0); v1 -= __builtin_amdgcn_cvt_f32_fp8(p0, 1);
            const int p1 = __builtin_amdgcn_cvt_pk_fp8_f32(v0, v1, 0, false); v0 -= __builtin_amdgcn_cvt_f32_fp8(p1, 0); v1 -= __builtin_amdgcn_cvt_f32_fp8(p1, 1);
            const int p2 = __builtin_amdgcn_cvt_pk_fp8_f32(v0, v1, 0, false);
            unsigned char* dst = C8 + (size_t)tO * 384 + cidx;
            dst[0] = (unsigned char)p0; dst[8] = (unsigned char)(p0 >> 8); dst[32] = (unsigned char)p1; dst[40] = (unsigned char)(p1 >> 8); dst[64] = (unsigned char)p2; dst[72] = (unsigned char)(p2 >> 8);
            if (lane == 0) OS[tO] = cm > 0.f ? cm * (1.f / 240.f) : 1.f;
            tO = -1; }
    };
    u32x4 e[4]; u32x2 xw = *(const u32x2*)(XB1 + (size_t)t * DM);
#pragma unroll
    for (int j = 0; j < 4; ++j) e[j] = *(const u32x4*)(IDX + (size_t)t * 128 + 4 * j);
    Rows8 A, B; issue8<0>(A, U4, loff, e);
    int k = 0;
    auto body = [&](const int ph) __attribute__((always_inline)) {
        const int tn = (k + 1 < cnt) ? tok(k + 1) : t;
        const u32x2 idraw = *(const u32x2*)((const unsigned*)(ws + WS_IDX) + (size_t)tn * 128 + 2 * lane);
        const u32x2 xwn = *(const u32x2*)(XB1 + (size_t)tn * DM);
        stage_top(ph, t, true);
        issue8<1>(B, U4, loff, e);
        P8_PIN;
        unsigned xh[4], xl[4]; float sx;
        {
            const float x0 = bflo(xw[0]), x1 = bfhi(xw[0]), x2 = bflo(xw[1]), x3 = bfhi(xw[1]);
            const float am = wave_max(fmaxf(fmaxf(fabsf(x0), fabsf(x1)), fmaxf(fabsf(x2), fabsf(x3))));
            sx = am > 0.f ? am * (1.f / 119.f) : 1.f; const float inv = __builtin_amdgcn_rcpf(sx); constexpr float MG = 12582912.f + 8.f;
            const unsigned u0 = __float_as_uint(fmaf(x0, inv, MG)), u1 = __float_as_uint(fmaf(x1, inv, MG)), u2 = __float_as_uint(fmaf(x2, inv, MG)), u3 = __float_as_uint(fmaf(x3, inv, MG));
            unsigned W = __builtin_amdgcn_perm(u1, u0, 0x0c0c0400u); W = __builtin_amdgcn_perm(u2, W, 0x0c040100u); W = __builtin_amdgcn_perm(u3, W, 0x04020100u);
            unsigned H = (W >> 4) & 0x0F0F0F0Fu, L = (W & 0x0F0F0F0Fu) ^ 0x08080808u;
            H |= H >> 4; L |= L >> 4;
            XS[8 * q + g] = __builtin_amdgcn_perm(L, H, 0x06040200u);
            const u32x4 d0 = *(const LAS u32x4*)(XS + 8 * q), d1 = *(const LAS u32x4*)(XS + 8 * q + 4);
            xh[0] = __builtin_amdgcn_perm(d0[1], d0[0], 0x05040100u); xl[0] = __builtin_amdgcn_perm(d0[1], d0[0], 0x07060302u);
            xh[1] = __builtin_amdgcn_perm(d0[3], d0[2], 0x05040100u); xl[1] = __builtin_amdgcn_perm(d0[3], d0[2], 0x07060302u);
            xh[2] = __builtin_amdgcn_perm(d1[1], d1[0], 0x05040100u); xl[2] = __builtin_amdgcn_perm(d1[1], d1[0], 0x07060302u);
            xh[3] = __builtin_amdgcn_perm(d1[3], d1[2], 0x05040100u); xl[3] = __builtin_amdgcn_perm(d1[3], d1[2], 0x07060302u);
        }
        int d[16];
        dot8<0>(A, xh, xl, d);
        P8_PIN;
        u32x4 en[4];
        { LAS unsigned* IDS = (LAS unsigned*)(lds + 69632 + wave * 512);
          *(LAS u32x2*)(IDS + 2 * lane) = idraw;
#pragma unroll
          for (int j = 0; j < 4; ++j) en[j] = *(const LAS u32x4*)(IDS + 16 * g + 4 * j); }
        issue8<0>(A, U4, loff, en);
        P8_PIN;
        dot8<8>(B, xh, xl, d);
        bfly16i<4, 2, 1>(d, q);
        __hip_atomic_store(AP + ((size_t)slice * T + t) * 64 + 8 * g + q, __builtin_bit_cast(unsigned, __builtin_convertvector((f32x2){(float)d[0] * sx, (float)d[1] * sx}, f16x2)), __ATOMIC_RELAXED, __HIP_MEMORY_SCOPE_AGENT);
        stage_end(ph);
#pragma unroll
        for (int j = 0; j < 4; ++j) e[j] = en[j];
        xw = xwn; idcur = idraw;
        t = tn; ++k;
    };
    while (k < cnt && ((k - own_k) & 3) != 0) body(3);
    while (k + 3 < cnt) { body(0); body(1); body(2); body(3); }
    if (k < cnt) body(0);
    if (k < cnt) body(1);
    if (k < cnt) body(2);
    { const int phn = (k - own_k) & 3;
      if (phn == 1) stage_top(1, 0, false);
      if (phn == 1 || phn == 2) { stage_top(2, 0, false); if (phn == 1) stage_end(1); stage_end(2); }
      stage_top(0, 0, false);
      stage_top(2, 0, false); stage_end(2); }
}
typedef int i32x2 __attribute__((ext_vector_type(2)));
typedef int i32x8 __attribute__((ext_vector_type(8)));
__device__ __forceinline__ void v_finalize4(float* orow, unsigned* S2u, int tok, unsigned w, const float (&xp)[16], const float (&gf)[16], int lane) {
    unsigned spins = 0;
    while (!__all(w != 0xFFFFFFFFu)) { w = __hip_atomic_load(S2u + (size_t)tok * NSL + (lane & 3), __ATOMIC_RELAXED, __HIP_MEMORY_SCOPE_AGENT); if (__all(w != 0xFFFFFFFFu)) break; __builtin_amdgcn_s_sleep(2); if (++spins > (1u << 20)) break; }
    const int wi = (int)w;
    const float sm = (__int_as_float(__builtin_amdgcn_mov_dpp(wi, 0x00, 0xf, 0xf, true)) + __int_as_float(__builtin_amdgcn_mov_dpp(wi, 0x55, 0xf, 0xf, true)))
                   + (__int_as_float(__builtin_amdgcn_mov_dpp(wi, 0xAA, 0xf, 0xf, true)) + __int_as_float(__builtin_amdgcn_mov_dpp(wi, 0xFF, 0xf, 0xf, true)));
    const float r = rsqrtf(sm * (1.f / DM) + EPS);
#pragma unroll
    for (int j = 0; j < 4; ++j) __builtin_nontemporal_store((f32x4){xp[4 * j] * r * gf[4 * j], xp[4 * j + 1] * r * gf[4 * j + 1], xp[4 * j + 2] * r * gf[4 * j + 2], xp[4 * j + 3] * r * gf[4 * j + 3]}, (f32x4*)orow + 16 * j);
}
__device__ __forceinline__ void p8b_v(const Args& a, LAS unsigned char* lds, int lane, int wave, int bid, int G) {
    unsigned char* ws = a.ws; const int slice = bid & 3, half = (bid >> 2) & 1, wsl = (bid >> 3) * NWAVES + wave, nws = (G >> 3) * NWAVES;
    const int n = lane & 15, fq = lane >> 4, r8 = lane >> 3, c8 = lane & 7;
    LAS unsigned char* buf = lds + wave * 16384;
    const unsigned char* V4s = ws + WS_VB + (size_t)slice * (NEXP * 128) + 16 * (c8 ^ r8);
    const unsigned* IDX = (const unsigned*)(ws + WS_IDX) + 4 * r8; const unsigned char* C8 = ws + WS_COEF; const float* OS = (const float*)(ws + WS_COEF_OS);
    const bf16* XB1 = (const bf16*)(ws + WS_XB1) + 256 * slice + 4 * n; unsigned* S2u = (unsigned*)(ws + WS_SSP2);
    const int ai = n & 3, af = n >> 2;
    const bool aact = ai < 3 && (af & 1) == (fq >> 1), ahi = af >= 2;
    const unsigned aoff = ai * 32 + 16 * (fq & 1);
    const unsigned tb0 = (unsigned)(32 * fq + n) * 128u + ((unsigned)(lane & 7) << 4);
    float gf[16];
#pragma unroll
    for (int nb = 0; nb < 16; ++nb) gf[nb] = a.in[I_GF][256 * slice + 64 * (nb >> 2) + 4 * n + (nb & 3)];
    int tp = -1; float xp[16];
#pragma unroll
    for (int nb = 0; nb < 16; ++nb) xp[nb] = 0.f;
    u32x4 id[4];
    if (wsl < T / 8) {
#pragma unroll
        for (int f = 0; f < 4; ++f) id[f] = *(const u32x4*)(IDX + (size_t)(half * (T / 2) + 4 * wsl + f) * 128); }
    for (int task = wsl; task < T / 8; task += nws) {
        const int tb = half * (T / 2) + 4 * task;
        f32x4 acc[16];
#pragma unroll
        for (int nb = 0; nb < 16; ++nb) acc[nb] = (f32x4){0.f, 0.f, 0.f, 0.f};
        const int tbn = task + nws < T / 8 ? tb + 4 * nws : tb;
        u32x4 xw0 = (u32x4){0u, 0u, 0u, 0u}, xw1 = xw0; float os = 0.f; unsigned pw = 0u;
#pragma unroll 1
        for (int s = 0; s < 4; ++s) {
            asm volatile("s_waitcnt lgkmcnt(0)" ::: "memory");
#pragma unroll
            for (int ii = 0; ii < 16; ++ii)
                __builtin_amdgcn_global_load_lds((const unsigned*)(V4s + ((size_t)id[ii >> 2][ii & 3] << 7)), (LAS unsigned*)(buf + ii * 1024), 16, 0, 0);
            u32x4 idn[4];
            { const unsigned* ip = IDX + (s < 3 ? (size_t)tb * 128 + 32 * (s + 1) : (size_t)tbn * 128);
#pragma unroll
              for (int f = 0; f < 4; ++f) idn[f] = *(const u32x4*)(ip + f * 128); }
            u32x4 cvec = (u32x4){0u, 0u, 0u, 0u};
            if (aact) cvec = *(const u32x4*)(C8 + (size_t)(tb + af) * 384 + aoff + 96 * s);
            if (s == 3) { const bf16* xr = XB1 + (size_t)(tb + fq) * DM; const u32x2 q0 = *(const u32x2*)xr, q1 = *(const u32x2*)(xr + 64), q2 = *(const u32x2*)(xr + 128), q3 = *(const u32x2*)(xr + 192);
                xw0 = (u32x4){q0[0], q0[1], q1[0], q1[1]}; xw1 = (u32x4){q2[0], q2[1], q3[0], q3[1]}; os = OS[tb + fq]; }
            if (s == 0 && tp >= 0) pw = __hip_atomic_load(S2u + (size_t)(tp + fq) * NSL + (lane & 3), __ATOMIC_RELAXED, __HIP_MEMORY_SCOPE_AGENT);
            asm volatile("s_waitcnt vmcnt(0)" ::: "memory");
            i32x8 A;
#pragma unroll
            for (int w = 0; w < 4; ++w) { A[w] = ahi ? 0 : (int)cvec[w]; A[4 + w] = ahi ? (int)cvec[w] : 0; }
#pragma unroll
            for (int nb = 0; nb < 16; ++nb) {
                const unsigned ad = (tb0 ^ (unsigned)((nb >> 1) << 4)) + 8u * (nb & 1);
                const i32x2 b0 = __builtin_amdgcn_ds_read_tr4_b64_v2i32((LAS i32x2*)(buf + ad)), b1 = __builtin_amdgcn_ds_read_tr4_b64_v2i32((LAS i32x2*)(buf + ad + 16 * 128));
                const i32x8 B = {b0[0], b0[1], b1[0], b1[1], 0, 0, 0, 0};
                acc[nb] = __builtin_amdgcn_mfma_scale_f32_16x16x128_f8f6f4(A, B, acc[nb], 0, 4, 0, 0x7F7F7F7F, 0, 0x7F7F7F7F);
            }
            asm volatile("" ::: "memory");
#pragma unroll
            for (int f = 0; f < 4; ++f) id[f] = idn[f];
            if (s == 0 && tp >= 0) v_finalize4(a.out + (size_t)(tp + fq) * DM + 256 * slice + 4 * n, S2u, tp + fq, pw, xp, gf, lane);
        }
        float ss = 0.f;
#pragma unroll
        for (int nb = 0; nb < 16; ++nb) { const unsigned xw = nb < 8 ? xw0[nb >> 1] : xw1[(nb - 8) >> 1]; const float x2 = ((nb & 1) ? bfhi(xw) : bflo(xw)) + ((acc[nb][0] + acc[nb][1]) + acc[nb][2]) * os; xp[nb] = x2; ss += x2 * x2; }
        ss += __int_as_float(__builtin_amdgcn_mov_dpp(__float_as_int(ss), 0xB1, 0xf, 0xf, true)); ss += __int_as_float(__builtin_amdgcn_mov_dpp(__float_as_int(ss), 0x4E, 0xf, 0xf, true));
        ss += __int_as_float(__builtin_amdgcn_update_dpp(0, __float_as_int(ss), 0x124, 0xf, 0xf, false)); ss += __int_as_float(__builtin_amdgcn_update_dpp(0, __float_as_int(ss), 0x128, 0xf, 0xf, false));
        if (n == 0) __hip_atomic_store(S2u + (size_t)(tb + fq) * NSL + slice, __float_as_uint(ss), __ATOMIC_RELAXED, __HIP_MEMORY_SCOPE_AGENT);
        tp = tb;
    }
    if (tp >= 0) v_finalize4(a.out + (size_t)(tp + fq) * DM + 256 * slice + 4 * n, S2u, tp + fq, 0xFFFFFFFFu, xp, gf, lane);
}

__global__ void __launch_bounds__(NTHREADS, 2) mk_fwd(Args a) {
    extern __shared__ __attribute__((aligned(16))) unsigned char lds_raw[];
    LAS unsigned char* lds = (LAS unsigned char*)lds_raw;
    const int tid = threadIdx.x, lane = tid & 63, wave = __builtin_amdgcn_readfirstlane(tid >> 6), bid = blockIdx.x, G = gridDim.x;
    unsigned char* ws = a.ws; unsigned* ctl = (unsigned*)(ws + WS_CTL);
    volatile LAS unsigned* MISC = (volatile LAS unsigned*)(lds + LDSCTL_OFF);
    for (int u = tid; u < 64; u += NTHREADS) MISC[u] = 0u;
    __syncthreads();
    XcdBarrier bar; bar.bar = ctl + CW_BAR; bar.x = 0; bar.st = nullptr;
    if (N_LAUNCHES == 1) bar = xcd_barrier_post(ctl + CW_BAR, MISC + 8);
    const int lo = a.ph_lo, hi = a.ph_hi;
#ifndef REP_PHASE
#define REP_PHASE -1
#endif
#define IN(k) (lo <= (k) && (k) < hi)
#define REP(k) for (int rep_ = 0; rep_ < ((REP_PHASE) == (k) ? 2 : 1); ++rep_)
#define SEAM(k) do { if (IN(k) && IN((k) + 1)) xcd_barrier(bar); } while (0)
    const int gw = bid * NWAVES + wave, NGW = G * NWAVES;

    if (IN(0)) {
        if (IN(1)) { p0_prologue<0>(a, lds, tid, lane, wave, bid, G); const XbTok k0 = xcd_arrive(bar); p0_prologue<1>(a, lds, tid, lane, wave, bid, G); xcd_wait(bar, k0); }
        else { REP(0) { p0_prologue<-1>(a, lds, tid, lane, wave, bid, G); __syncthreads(); } } }
    const int x_nloc = (int)MISC[8], x_nx = (int)MISC[9], x_xi = (int)MISC[10], x_rank = (int)MISC[11]; const bool x_m8 = MISC[12] != 0u;
    const int x_npair = x_xi < NBH / 2 ? (NBH / 2 - x_xi + x_nx - 1) / x_nx : 0, x_nseq = 2 * x_npair;
    auto seq_of = [&](int ls) { return 2 * (x_xi + x_nx * (ls >> 1)) + (ls & 1); };
    if (IN(1)) { REP(1) {
        for (int lt = x_rank * NWAVES + wave; lt < x_nseq * NCH; lt += x_nloc * NWAVES) p1_stats(a, lane, seq_of(lt >> 6) * NCH + (lt & 63));
        pg8::Gemm g{(const bf16*)(ws + WS_XB), (const bf16*)(ws + WS_W1T), T, NZ, DM}; pg8::Z1Order S; S.init(SEQ / 256, NBH / 2, x_xi, x_nx, x_rank, x_nloc);
        EpiZ E{(bf16*)(ws + WS_Z), NZ, (const float*)(ws + WS_RS1), 8};
        pg8::gemm_phase<EpiZ, pg8::Z1Order, true, true>(lds, g, S, E); }
        if (IN(2)) xcd_local_barrier(bar);
    }
    const bool x_sp = IN(2) && IN(3) && IN(4);
    auto gmlp_tasks = [&](int par) { int j = 0;
        for (int lt = x_rank; lt < x_npair * 64; lt += x_nloc, ++j) { if (par >= 0 && (j & 1) != par) continue;
            const int pr = x_xi + x_nx * (lt >> 6), w = lt & 63;
            p2_gmlp_task(a, lds, tid, lane, wave, (pr >> 1) * 128 + (w >> 1) * 4 + 2 * (pr & 1) + (w & 1)); } };
    if (IN(2)) {
        for (int lt = x_rank; lt < x_nseq * NCH; lt += x_nloc) p2_dc_task(a, lds, tid, lane, wave, seq_of(lt >> 6) * NCH + (lt & 63));
        if (x_sp) { const unsigned g1 = xcd_local_arrive(bar); gmlp_tasks(0); xcd_local_wait(bar, g1); }
        else { gmlp_tasks(-1); if (IN(3)) xcd_local_barrier(bar); }
    }
    if (IN(3)) { p3_scan(a, lds, tid, x_rank, x_nloc, x_xi, x_nx);
        if (x_sp) { const unsigned g2 = xcd_local_arrive(bar); gmlp_tasks(1); xcd_local_wait(bar, g2); }
        else if (IN(4)) xcd_local_barrier(bar); }
    if (IN(4)) { REP(4) for (int lt = x_rank; lt < x_nseq * NCH; lt += x_nloc) p4_out_task(a, lds, tid, lane, wave, seq_of(lt >> 6) * NCH + (lt & 63)); SEAM(4); }
    if (IN(5)) { REP(5) {
        pg8::Gemm g{(const bf16*)(ws + WS_Y), (const bf16*)(ws + WS_WOT), T, DM, DM}; pg8::XcdOrder S; S.init(T, DM, x_xi, x_nx, x_rank, x_nloc);
        EpiX1 E{a.in[I_X], (bf16*)(ws + WS_XB1), (float*)(ws + WS_SSP)};
        pg8::gemm_phase<EpiX1, pg8::XcdOrder, true, true>(lds, g, S, E);
        }
        if (IN(6)) xcd_local_barrier(bar);
    }
    if (IN(6)) { REP(6) {
        pg8::Gemm g{(const bf16*)(ws + WS_XB1), (const bf16*)(ws + WS_WQT), T, 2048, DM}; pg8::XcdOrder S; S.init(T, 2048, x_xi, x_nx, x_rank, x_nloc);
        EpiQ E{(bf16*)(ws + WS_Q), 2048, (const float*)(ws + WS_SSP), (float*)(ws + WS_RS1)};
        pg8::gemm_phase<EpiQ, pg8::XcdOrder, true, true>(lds, g, S, E); }
        if (IN(7)) { if (x_m8) { const unsigned g6 = xcd_local_arrive(bar); p7_pre(a, lds, tid, bid, G, x_rank & 7); xcd_local_wait(bar, g6); } else xcd_barrier(bar); }
    }
    if (IN(7)) { P7Map M;
        if (x_m8) { const int nrowx = x_xi < T / 256 ? (T / 256 - x_xi + x_nx - 1) / x_nx : 0, nsub = x_nloc >> 3;
            M.h = x_rank & 7; M.first = x_rank >> 3; M.step = nsub; M.cnt = (4 * nrowx - M.first + nsub - 1) / nsub; if (M.cnt < 0) M.cnt = 0; M.local = 1; M.xi = x_xi; M.nx = x_nx; }
        else { const int slot = bid >> 3, nslot = G >> 3; M.h = bid & 7; M.first = slot; M.step = nslot; M.cnt = slot < T / 64 ? (T / 64 - slot + nslot - 1) / nslot : 0; M.local = 0; M.xi = 0; M.nx = 1; }
        REP(7) p7_topk(a, lds, tid, lane, wave, bid, G, M, x_m8 && IN(6)); SEAM(7); }
    if (IN(8)) { REP(8) p8a_u(a, lds, lane, wave, bid, G); SEAM(8); }
    if (IN(9)) { p8b_v(a, lds, lane, wave, bid, G); }
#undef IN
#undef SEAM
}

extern "C" void kernel_launch(void* const* d_in, const int* in_sizes, int n_in, void* d_out, int out_size, void* d_ws, size_t ws_size, hipStream_t stream) {
    static int grid = 0;
    if (grid == 0) {
        if (n_in != 19 || in_sizes[0] != T * DM || out_size != T * DM || ws_size < WS_END) { fprintf(stderr, "kernel_launch: unexpected shapes (n_in %d, in0 %d, out %d, ws %zu); nothing launched\n", n_in, n_in > 0 ? in_sizes[0] : -1, out_size, ws_size); grid = -1; return; }
        int dev = 0, cus = 0;
        if (hipGetDevice(&dev) != hipSuccess || hipDeviceGetAttribute(&cus, hipDeviceAttributeMultiprocessorCount, dev) != hipSuccess) { grid = -1; return; }
        if (hipFuncSetAttribute((const void*)mk_fwd, hipFuncAttributeMaxDynamicSharedMemorySize, LDS_BYTES) != hipSuccess) { fprintf(stderr, "kernel_launch: hipFuncSetAttribute failed\n"); grid = -1; return; }
        (void)hipGetLastError();
        grid = cus;
    }
    if (grid < 0) return;
    (void)hipMemsetAsync((char*)d_ws + WS_CTL, 0, CTL_ZERO_BYTES, stream);
    Args a{};
    for (int i = 0; i < 19; ++i) a.in[i] = (const float*)d_in[i];
    a.out = (float*)d_out; a.ws = (unsigned char*)d_ws;
    if (N_LAUNCHES == 1) { a.ph_lo = 0; a.ph_hi = NPHASE; hipLaunchKernelGGL(mk_fwd, dim3(grid), dim3(NTHREADS), LDS_BYTES, stream, a); }
    else for (int p = 0; p < NPHASE; ++p) { a.ph_lo = p; a.ph_hi = p + 1; hipLaunchKernelGGL(mk_fwd, dim3(grid), dim3(NTHREADS), LDS_BYTES, stream, a); }
}
```
